# Optimizing an MI355X kernel written in HIP

```python
import math
import jax, jax.numpy as jnp
from jax import lax
import numpy as np

D_MODEL = 1024
BATCH = 16
SEQ = 256
DEPTH = 4
DEC_BATCH = 4
DEC_SEQ = 1024
PAST_LEN = 256

GRID_W = 64
N_BRANCH = 4
BRANCH_W = 256
RET_HEADS = 4
RET_DK = 64
RET_DV = 64
S5_GROUPS = 16
S5_GROUP_CH = 16
S5_STATE = 64
GLA_HEADS = 4
GLA_DK = 32
GLA_DV = 64
GLA_RANK = 16
GLA_TAU = 16.0
NA_HEADS = 4
NA_DH = 64
NA_WIN_H = 8
NA_WIN_W = 16
D_FF = 4 * D_MODEL
CHUNK = 64
QBLOCK = 128
ROPE_BASE = 10000.0
EPS = 1e-6

IN_SIZES = (RET_HEADS * RET_DK, RET_HEADS * RET_DK, RET_HEADS * RET_DV, RET_HEADS * RET_DV,
            S5_GROUPS * S5_GROUP_CH,
            GLA_HEADS * GLA_DK, GLA_HEADS * GLA_DK, GLA_HEADS * GLA_DV, GLA_HEADS * GLA_DV, 2 * GLA_RANK,
            NA_HEADS * NA_DH, NA_HEADS * NA_DH, NA_HEADS * NA_DH)
D_IN = sum(IN_SIZES)

kernel_name = 'hybrid_diffusion_gated_branch_step'


def _in_offsets():
    return [int(o) for o in np.cumsum(IN_SIZES)[:-1]]


def _flip(a):
    return jnp.flip(a, axis=1)


def rmsnorm(x, g):
    xf = x.astype(jnp.float32)
    y = xf * lax.rsqrt(jnp.mean(xf * xf, axis=-1, keepdims=True) + EPS)
    return (y * g.astype(jnp.float32)).astype(x.dtype)


def head_norm(o, g):
    B, L, H, d = o.shape
    of = o.astype(jnp.float32)
    mu = jnp.mean(of, axis=-1, keepdims=True)
    xc = of - mu
    y = xc * lax.rsqrt(jnp.mean(xc * xc, axis=-1, keepdims=True) + EPS)
    return y.reshape(B, L, H * d) * g.astype(jnp.float32)


def axial_rope(x):
    B, L, H, d = x.shape
    half = d // 2
    nf = half // 2
    t = jnp.arange(L)
    row = (t // GRID_W).astype(jnp.float32)
    col = (t % GRID_W).astype(jnp.float32)
    inv = ROPE_BASE ** (-jnp.arange(nf, dtype=jnp.float32) / nf)

    def rot(xa, pos):
        ang = pos[:, None] * inv[None, :]
        cos = jnp.cos(ang)[None, :, None, :]
        sin = jnp.sin(ang)[None, :, None, :]
        x1, x2 = xa[..., :nf], xa[..., nf:]
        return jnp.concatenate([x1 * cos - x2 * sin, x1 * sin + x2 * cos], axis=-1)

    xf = x.astype(jnp.float32)
    return jnp.concatenate([rot(xf[..., :half], row), rot(xf[..., half:], col)], axis=-1).astype(x.dtype)


def _chunks(a, B, n, H):
    return a.astype(jnp.float32).reshape(B, n, CHUNK, H, a.shape[-1]).transpose(1, 0, 3, 2, 4)


def retention_scan(q, k, v, log_gamma, s0):
    B, L, H, _ = q.shape
    dv = v.shape[-1]
    n = L // CHUNK
    lg = log_gamma.astype(jnp.float32)
    pos = jnp.arange(CHUNK, dtype=jnp.float32)
    rel = pos[:, None] - pos[None, :]
    causal = rel >= 0
    decay = jnp.where(causal[None], jnp.exp(lg[:, None, None] * jnp.where(causal, rel, 0.0)[None]), 0.0)
    q_dec = jnp.exp(lg[:, None] * (pos + 1.0)[None])
    k_dec = jnp.exp(lg[:, None] * (CHUNK - 1.0 - pos)[None])
    c_dec = jnp.exp(lg * CHUNK)

    def step(s, inp):
        qc, kc, vc = inp
        scores = jnp.einsum('bhid,bhjd->bhij', qc, kc) * decay[None]
        o = (jnp.einsum('bhij,bhjv->bhiv', scores, vc)
             + jnp.einsum('bhid,bhdv->bhiv', qc * q_dec[None, :, :, None], s))
        s = c_dec[None, :, None, None] * s + jnp.einsum('bhjd,bhjv->bhdv', kc * k_dec[None, :, :, None], vc)
        return s, o

    s_fin, o = lax.scan(step, s0.astype(jnp.float32),
                        (_chunks(q, B, n, H), _chunks(k, B, n, H), _chunks(v, B, n, H)))
    return o.transpose(1, 0, 3, 2, 4).reshape(B, L, H, dv), s_fin


def gla_scan(q, k, v, log_a, s0):
    B, L, H, _ = q.shape
    dv = v.shape[-1]
    n = L // CHUNK
    causal = jnp.tril(jnp.ones((CHUNK, CHUNK), dtype=bool))

    def step(s, inp):
        qc, kc, vc, gc = inp
        b = jnp.cumsum(gc, axis=2)
        diff = b[:, :, :, None, :] - b[:, :, None, :, :]
        w = jnp.exp(jnp.where(causal[None, None, :, :, None], diff, -jnp.inf))
        attn = jnp.einsum('bhid,bhjd,bhijd->bhij', qc, kc, w)
        o = (jnp.einsum('bhij,bhjv->bhiv', attn, vc)
             + jnp.einsum('bhid,bhdv->bhiv', qc * jnp.exp(b), s))
        b_end = b[:, :, -1, :]
        s = (jnp.exp(b_end)[..., None] * s
             + jnp.einsum('bhjd,bhjv->bhdv', kc * jnp.exp(b_end[:, :, None, :] - b), vc))
        return s, o

    s_fin, o = lax.scan(step, s0.astype(jnp.float32),
                        (_chunks(q, B, n, H), _chunks(k, B, n, H), _chunks(v, B, n, H), _chunks(log_a, B, n, H)))
    return o.transpose(1, 0, 3, 2, 4).reshape(B, L, H, dv), s_fin


def _ssm_combine(e1, e2):
    a1, b1 = e1
    a2, b2 = e2
    return a1 * a2, a2 * b1 + b2


def s5_scan(u, lam_re, lam_im, log_dt, b_re, b_im, c_re, c_im, x0):
    L = u.shape[1]
    lam = lax.complex(lam_re.astype(jnp.float32), lam_im.astype(jnp.float32))
    lam_dt = lam * jnp.exp(log_dt.astype(jnp.float32))[:, None]
    lam_bar = jnp.exp(lam_dt)
    b_bar = ((lam_bar - 1.0) / lam)[:, :, None] * lax.complex(b_re.astype(jnp.float32), b_im.astype(jnp.float32))
    c_mat = lax.complex(c_re.astype(jnp.float32), c_im.astype(jnp.float32))
    bu = jnp.einsum('blgh,gph->blgp', u.astype(jnp.complex64), b_bar)
    a = jnp.broadcast_to(lam_bar, bu.shape)
    _, xs = lax.associative_scan(_ssm_combine, (a, bu), axis=1)
    steps = jnp.arange(1, L + 1, dtype=jnp.float32)
    xs = xs + jnp.exp(lam_dt[None] * steps[:, None, None])[None] * x0[:, None]
    y = jnp.einsum('ghp,blgp->blgh', c_mat, xs).real
    return y, xs[:, -1]


def s5_direction(u, lp, d, x0):
    return s5_scan(u, lp['s5_lambda_re'][d], lp['s5_lambda_im'][d], lp['s5_log_dt'][d],
                   lp['s5_b_re'][d], lp['s5_b_im'][d], lp['s5_c_re'][d], lp['s5_c_im'][d], x0)


def context_attention(q, k, v):
    B, L, H, d = q.shape
    nb = L // QBLOCK
    scale = d ** -0.5
    qb = q.reshape(B, nb, QBLOCK, H, d).transpose(1, 0, 2, 3, 4)

    def blk(qi):
        s = jnp.einsum('bqhd,bkhd->bhqk', qi, k).astype(jnp.float32) * scale
        p = jax.nn.softmax(s, axis=-1)
        return jnp.einsum('bhqk,bkhd->bqhd', p, v.astype(jnp.float32))

    o = lax.map(blk, qb)
    return o.transpose(1, 0, 2, 3, 4).reshape(B, L, H, d)


def na_latent(q, k, v, k_ctx, v_ctx, rpb):
    B, L, H, d = q.shape
    rows = L // GRID_W
    kh = min(NA_WIN_H, rows)
    scale = d ** -0.5
    qg = q.reshape(B, rows, GRID_W, H, d)
    kg = k.reshape(B, rows, GRID_W, H, d)
    vg = v.reshape(B, rows, GRID_W, H, d)
    col = jnp.arange(GRID_W)
    col_start = jnp.clip(col - NA_WIN_W // 2, 0, GRID_W - NA_WIN_W)
    col_in = (col[None, :] >= col_start[:, None]) & (col[None, :] < col_start[:, None] + NA_WIN_W)
    col_idx = jnp.clip(col[None, :] - col[:, None] + NA_WIN_W - 1, 0, 2 * NA_WIN_W - 2)
    rpb_cols = rpb[:, :, col_idx]
    n_loc = kh * GRID_W

    def row_fn(r):
        rs = jnp.clip(r - kh // 2, 0, rows - kh)
        q_r = lax.dynamic_index_in_dim(qg, r, axis=1, keepdims=False)
        k_r = lax.dynamic_slice_in_dim(kg, rs, kh, axis=1)
        v_r = lax.dynamic_slice_in_dim(vg, rs, kh, axis=1)
        row_idx = rs + jnp.arange(kh) - r + NA_WIN_H - 1
        bias = jnp.take(rpb_cols, row_idx, axis=1).transpose(0, 2, 1, 3)
        s_loc = jnp.einsum('bqhd,bikhd->bhqik', q_r, k_r).astype(jnp.float32) * scale + bias[None]
        s_loc = jnp.where(col_in[None, None, :, None, :], s_loc, -jnp.inf).reshape(B, H, GRID_W, n_loc)
        s_ctx = jnp.einsum('bqhd,bchd->bhqc', q_r, k_ctx).astype(jnp.float32) * scale
        p = jax.nn.softmax(jnp.concatenate([s_loc, s_ctx], axis=-1), axis=-1)
        return (jnp.einsum('bhqn,bnhd->bqhd', p[..., :n_loc], v_r.reshape(B, n_loc, H, d).astype(jnp.float32))
                + jnp.einsum('bhqc,bchd->bqhd', p[..., n_loc:], v_ctx.astype(jnp.float32)))

    o = lax.map(row_fn, jnp.arange(rows))
    return o.transpose(1, 0, 2, 3, 4).reshape(B, L, H, d)


def token_mixer(h, lp, cache):
    B, L, _ = h.shape
    latent = cache is not None
    proj = h @ lp['w_in']
    (rq, rk, rv, rg, su, gq, gk, gv, gg, glr, nq, nk, nv) = jnp.split(proj, _in_offsets(), axis=-1)
    if latent:
        c_k, c_v, st_ret0, st_s5_0, st_gla0 = cache
        s5_x0 = lax.complex(st_s5_0[..., 0].astype(jnp.float32), st_s5_0[..., 1].astype(jnp.float32))
    else:
        st_ret0 = jnp.zeros((B, 2, RET_HEADS, RET_DK, RET_DV), jnp.float32)
        s5_x0 = jnp.zeros((B, 2, S5_GROUPS, S5_STATE), jnp.complex64)
        st_gla0 = jnp.zeros((B, 2, GLA_HEADS, GLA_DK, GLA_DV), jnp.float32)

    rq = rq.reshape(B, L, RET_HEADS, RET_DK)
    rk = rk.reshape(B, L, RET_HEADS, RET_DK)
    rv = rv.reshape(B, L, RET_HEADS, RET_DV)
    if latent:
        rq = axial_rope(rq)
        rk = axial_rope(rk)
    rk = rk * RET_DK ** -0.5
    o_f, sr_f = retention_scan(rq, rk, rv, lp['ret_log_decay'][0], st_ret0[:, 0])
    o_b, sr_b = retention_scan(_flip(rq), _flip(rk), _flip(rv), lp['ret_log_decay'][1], st_ret0[:, 1])
    ret_out = head_norm(o_f + _flip(o_b), lp['ret_gn']) * jax.nn.silu(rg.astype(jnp.float32))

    u = su.reshape(B, L, S5_GROUPS, S5_GROUP_CH).astype(jnp.float32)
    y_f, xs_f = s5_direction(u, lp, 0, s5_x0[:, 0])
    y_b, xs_b = s5_direction(_flip(u), lp, 1, s5_x0[:, 1])
    y = y_f + _flip(y_b) + lp['s5_d'].astype(jnp.float32).reshape(S5_GROUPS, S5_GROUP_CH) * u
    y = jax.nn.gelu(y.reshape(B, L, BRANCH_W))
    glu_a, glu_g = jnp.split(y @ lp['s5_w_glu'] + lp['s5_b_glu'], 2, axis=-1)
    s5_out = glu_a * jax.nn.sigmoid(glu_g)

    gq = gq.reshape(B, L, GLA_HEADS, GLA_DK) * GLA_DK ** -0.5
    gk = gk.reshape(B, L, GLA_HEADS, GLA_DK)
    gv = gv.reshape(B, L, GLA_HEADS, GLA_DV)
    lr_f, lr_b = jnp.split(glr, 2, axis=-1)
    la_f = (jax.nn.log_sigmoid((lr_f @ lp['gla_w_gate'][0] + lp['gla_b_gate'][0]).astype(jnp.float32))
            / GLA_TAU).reshape(B, L, GLA_HEADS, GLA_DK)
    la_b = (jax.nn.log_sigmoid((lr_b @ lp['gla_w_gate'][1] + lp['gla_b_gate'][1]).astype(jnp.float32))
            / GLA_TAU).reshape(B, L, GLA_HEADS, GLA_DK)
    og_f, sg_f = gla_scan(gq, gk, gv, la_f, st_gla0[:, 0])
    og_b, sg_b = gla_scan(_flip(gq), _flip(gk), _flip(gv), _flip(la_b), st_gla0[:, 1])
    gla_out = head_norm(og_f + _flip(og_b), lp['gla_gn']) * jax.nn.silu(gg.astype(jnp.float32))

    nq = nq.reshape(B, L, NA_HEADS, NA_DH)
    nk = nk.reshape(B, L, NA_HEADS, NA_DH)
    nv = nv.reshape(B, L, NA_HEADS, NA_DH)
    if latent:
        na_o = na_latent(nq, nk, nv, c_k, c_v, lp['na_rpb'])
    else:
        na_o = context_attention(nq, nk, nv)
    na_out = na_o.reshape(B, L, BRANCH_W)

    branches = jnp.stack([ret_out, s5_out, gla_out, na_out], axis=2).astype(h.dtype)
    up = jnp.einsum('blnw,nwd->blnd', branches, lp['w_branch'])
    gates = jax.nn.sigmoid(h @ lp['w_merge'] + lp['b_merge']).reshape(B, L, N_BRANCH, D_MODEL)
    out = jnp.sum(gates * up, axis=2) @ lp['w_out']
    if latent:
        return out, None
    st_s5 = jnp.stack([xs_f, xs_b], axis=1)
    new = (nk, nv, jnp.stack([sr_f, sr_b], axis=1),
           jnp.stack([st_s5.real, st_s5.imag], axis=-1),
           jnp.stack([sg_f, sg_b], axis=1))
    return out, new


def trunk_layer(x, mod, lp, cache):
    sh1, sc1, g1, sh2, sc2, g2 = jnp.split(mod, 6, axis=-1)
    h = rmsnorm(x, lp['g_norm'][0]) * (1.0 + sc1) + sh1
    m, ctx_tensors = token_mixer(h, lp, cache)
    x = x + g1 * rmsnorm(m, lp['g_norm'][1])
    h = rmsnorm(x, lp['g_norm'][2]) * (1.0 + sc2) + sh2
    f = jnp.square(jax.nn.relu(h @ lp['w_mlp1'])) @ lp['w_mlp2']
    x = x + g2 * rmsnorm(f, lp['g_norm'][3])
    return x, ctx_tensors


def setup_inputs(seed: int = 0) -> dict:
    key = jax.random.key(seed)
    ks = jax.random.split(key, 36)

    def nrm(k, shape, s):
        return jax.random.normal(k, shape, jnp.float32) * s

    ret_base = jnp.log(1.0 - 2.0 ** (-5.0 - jnp.arange(RET_HEADS, dtype=jnp.float32)))
    return {
        'x_prompt': nrm(ks[0], (BATCH, SEQ, D_MODEL), 1.0),
        'x_sample': nrm(ks[1], (DEC_BATCH, DEC_SEQ, D_MODEL), 1.0),
        'c': nrm(ks[2], (DEC_BATCH, D_MODEL), 1.0),
        'cache_na_k': nrm(ks[3], (DEC_BATCH, DEPTH, PAST_LEN, NA_HEADS, NA_DH), 1.0),
        'cache_na_v': nrm(ks[4], (DEC_BATCH, DEPTH, PAST_LEN, NA_HEADS, NA_DH), 1.0),
        'state_ret': nrm(ks[5], (DEC_BATCH, DEPTH, 2, RET_HEADS, RET_DK, RET_DV), 1.0),
        'state_s5': nrm(ks[6], (DEC_BATCH, DEPTH, 2, S5_GROUPS, S5_STATE, 2), 0.3),
        'state_gla': nrm(ks[7], (DEC_BATCH, DEPTH, 2, GLA_HEADS, GLA_DK, GLA_DV), 1.0),
        'c_ctx': nrm(ks[8], (D_MODEL,), 1.0),
        'w_ada': nrm(ks[9], (DEPTH, D_MODEL, 6 * D_MODEL), 0.5 * D_MODEL ** -0.5),
        'b_ada': nrm(ks[10], (DEPTH, 6 * D_MODEL), 0.02),
        'g_norm': 1.0 + nrm(ks[11], (DEPTH, 4, D_MODEL), 0.02),
        'w_in': nrm(ks[12], (DEPTH, D_MODEL, D_IN), D_MODEL ** -0.5),
        'ret_log_decay': ret_base[None, None, :] * (1.0 + nrm(ks[13], (DEPTH, 2, RET_HEADS), 0.05)),
        'ret_gn': 1.0 + nrm(ks[14], (DEPTH, BRANCH_W), 0.02),
        's5_lambda_re': -0.5 + nrm(ks[15], (DEPTH, 2, S5_GROUPS, S5_STATE), 0.01),
        's5_lambda_im': math.pi * jnp.arange(S5_STATE, dtype=jnp.float32) + nrm(ks[16], (DEPTH, 2, S5_GROUPS, S5_STATE), 0.01),
        's5_log_dt': jax.random.uniform(ks[17], (DEPTH, 2, S5_GROUPS), jnp.float32, math.log(1e-3), math.log(1e-1)),
        's5_b_re': nrm(ks[18], (DEPTH, 2, S5_GROUPS, S5_STATE, S5_GROUP_CH), (2 * S5_GROUP_CH) ** -0.5),
        's5_b_im': nrm(ks[19], (DEPTH, 2, S5_GROUPS, S5_STATE, S5_GROUP_CH), (2 * S5_GROUP_CH) ** -0.5),
        's5_c_re': nrm(ks[20], (DEPTH, 2, S5_GROUPS, S5_GROUP_CH, S5_STATE), S5_STATE ** -0.5),
        's5_c_im': nrm(ks[21], (DEPTH, 2, S5_GROUPS, S5_GROUP_CH, S5_STATE), S5_STATE ** -0.5),
        's5_d': nrm(ks[22], (DEPTH, BRANCH_W), 1.0),
        's5_w_glu': nrm(ks[23], (DEPTH, BRANCH_W, 2 * BRANCH_W), BRANCH_W ** -0.5),
        's5_b_glu': nrm(ks[24], (DEPTH, 2 * BRANCH_W), 0.02),
        'gla_w_gate': nrm(ks[25], (DEPTH, 2, GLA_RANK, GLA_HEADS * GLA_DK), GLA_RANK ** -0.5),
        'gla_b_gate': nrm(ks[26], (DEPTH, 2, GLA_HEADS * GLA_DK), 0.1),
        'gla_gn': 1.0 + nrm(ks[27], (DEPTH, BRANCH_W), 0.02),
        'na_rpb': nrm(ks[28], (DEPTH, NA_HEADS, 2 * NA_WIN_H - 1, 2 * NA_WIN_W - 1), 0.02),
        'w_branch': nrm(ks[29], (DEPTH, N_BRANCH, BRANCH_W, D_MODEL), BRANCH_W ** -0.5),
        'w_merge': nrm(ks[30], (DEPTH, D_MODEL, N_BRANCH * D_MODEL), D_MODEL ** -0.5),
        'b_merge': nrm(ks[31], (DEPTH, N_BRANCH * D_MODEL), 0.02),
        'w_out': nrm(ks[32], (DEPTH, D_MODEL, D_MODEL), D_MODEL ** -0.5),
        'w_mlp1': nrm(ks[33], (DEPTH, D_MODEL, D_FF), D_MODEL ** -0.5),
        'w_mlp2': nrm(ks[34], (DEPTH, D_FF, D_MODEL), D_FF ** -0.5),
    }


def reference(x_prompt, x_sample, c, cache_na_k, cache_na_v, state_ret, state_s5, state_gla,
              c_ctx, w_ada, b_ada, g_norm, w_in, ret_log_decay, ret_gn,
              s5_lambda_re, s5_lambda_im, s5_log_dt, s5_b_re, s5_b_im, s5_c_re, s5_c_im,
              s5_d, s5_w_glu, s5_b_glu, gla_w_gate, gla_b_gate, gla_gn, na_rpb,
              w_branch, w_merge, b_merge, w_out, w_mlp1, w_mlp2):
    y_prompt = x_prompt
    y_sample = x_sample
    ks_l, vs_l, ret_l, s5_l, gla_l = [], [], [], [], []
    for l in range(DEPTH):
        lp = {'g_norm': g_norm[l], 'w_in': w_in[l], 'ret_log_decay': ret_log_decay[l], 'ret_gn': ret_gn[l],
              's5_lambda_re': s5_lambda_re[l], 's5_lambda_im': s5_lambda_im[l], 's5_log_dt': s5_log_dt[l],
              's5_b_re': s5_b_re[l], 's5_b_im': s5_b_im[l], 's5_c_re': s5_c_re[l], 's5_c_im': s5_c_im[l],
              's5_d': s5_d[l], 's5_w_glu': s5_w_glu[l], 's5_b_glu': s5_b_glu[l],
              'gla_w_gate': gla_w_gate[l], 'gla_b_gate': gla_b_gate[l], 'gla_gn': gla_gn[l],
              'na_rpb': na_rpb[l], 'w_branch': w_branch[l], 'w_merge': w_merge[l], 'b_merge': b_merge[l],
              'w_out': w_out[l], 'w_mlp1': w_mlp1[l], 'w_mlp2': w_mlp2[l]}
        mod_ctx = (jax.nn.silu(c_ctx) @ w_ada[l] + b_ada[l])[None, None, :]
        y_prompt, (k_l, v_l, r_l, s_l, g_l) = trunk_layer(y_prompt, mod_ctx, lp, None)
        ks_l.append(k_l)
        vs_l.append(v_l)
        ret_l.append(r_l)
        s5_l.append(s_l)
        gla_l.append(g_l)
        mod_lat = (jax.nn.silu(c) @ w_ada[l] + b_ada[l])[:, None, :]
        cache_l = (cache_na_k[:, l], cache_na_v[:, l], state_ret[:, l], state_s5[:, l], state_gla[:, l])
        y_sample, _ = trunk_layer(y_sample, mod_lat, lp, cache_l)
    new_na_k = jnp.stack(ks_l, axis=1)
    new_na_v = jnp.stack(vs_l, axis=1)
    new_state_ret = jnp.stack(ret_l, axis=1)
    new_state_s5 = jnp.stack(s5_l, axis=1)
    new_state_gla = jnp.stack(gla_l, axis=1)
    return (y_prompt, y_sample, new_na_k, new_na_v, new_state_ret, new_state_s5, new_state_gla)
```

```cpp
#include <hip/hip_runtime.h>
#include <hip/hip_cooperative_groups.h>
#include <cstdio>
#include <cstdint>
namespace cg = cooperative_groups;

#define LAS __attribute__((address_space(3)))
#define GAS __attribute__((address_space(1)))
typedef unsigned short bf16_t;
typedef short bf16x8 __attribute__((ext_vector_type(8)));
typedef float f32x4 __attribute__((ext_vector_type(4)));
typedef unsigned u32x4 __attribute__((ext_vector_type(4)));
typedef unsigned u32x2 __attribute__((ext_vector_type(2)));

constexpr int T_ALL = 8192, T_CTX = 4096, DM = 1024, NPROJ = 3072, NGATE = 4096, DFF = 4096;
constexpr int C_RQ = 0, C_RK = 256, C_RV = 512, C_RG = 768, C_SU = 1024, C_GQ = 1280, C_GK = 1408, C_GV = 1536, C_GG = 1792,
              C_NQ = 2048, C_NK = 2304, C_NV = 2560, C_GLR = 2816;
constexpr float EPS = 1e-6f;
enum { I_XP = 0, I_XS, I_C, I_CK, I_CV, I_SRET, I_SS5, I_SGLA, I_CCTX, I_WADA, I_BADA, I_GN, I_WIN, I_RLD, I_RGN, I_S5LR, I_S5LI, I_S5DT,
       I_S5BR, I_S5BI, I_S5CR, I_S5CI, I_S5D, I_S5WG, I_S5BG, I_GWG, I_GBG, I_GGN, I_RPB, I_WBR, I_WMG, I_BMG, I_WOUT, I_W1, I_W2, N_IN };
constexpr size_t O_X = 0, O_NAK = 8388608, O_NAV = 12582912, O_RET = 16777216, O_S5 = 18874368, O_GLA = 19136512;
constexpr size_t WL_CAT = 0, WL_BR = 14680064, WL_OUT = WL_BR + 2097152, WL_M1 = WL_OUT + 2097152, WL_M2 = WL_M1 + 8388608, WL_GLU = WL_M2 + 8388608,
                 WL_STRIDE = WL_GLU + 262144;
constexpr size_t WS_W = 0, WS_MOD = WS_W + 4 * WL_STRIDE, WS_H = WS_MOD + 491520, WS_PROJ = WS_H + 16777216, WS_GATES = WS_PROJ + 50331648,
                 WS_BR = WS_GATES + 67108864, WS_MERGED = WS_BR + 16777216, WS_PART = WS_MERGED + 16777216, WS_TAB = WS_PART + 67108864, WS_BAR = WS_TAB + 4096, WS_CTR = WS_BAR + 16384, WS_END = WS_CTR + 4096;
constexpr size_t WS_S5Y = WS_PART, WS_RETS = WS_PART + 16777216, WS_GLAS = WS_RETS + 8388608, WS_S5E = WS_GLAS + 4194304;
constexpr int LDS_MAIN = 131072, LDS_BYTES = LDS_MAIN + 64;

struct Params { const float* in[N_IN]; float* out; unsigned char* ws; int ph_lo, ph_hi; };
struct Ctx { const GAS float* const* in; float* out; unsigned char* ws; };
#define PIN(i) ((const float*)(p.in[i]))

typedef float f32x2_t __attribute__((ext_vector_type(2)));
typedef __bf16 bf16x2_t __attribute__((ext_vector_type(2)));
__device__ __forceinline__ unsigned pk2(float lo, float hi) { const f32x2_t v = {lo, hi}; const bf16x2_t h = __builtin_convertvector(v, bf16x2_t); return __builtin_bit_cast(unsigned, h); }
__device__ __forceinline__ bf16_t f2bf(float f) { return (bf16_t)(pk2(f, 0.f) & 0xffffu); }
__device__ __forceinline__ float bflo(unsigned u) { return __uint_as_float(u << 16); }
__device__ __forceinline__ float bfhi(unsigned u) { return __uint_as_float(u & 0xffff0000u); }
__device__ __forceinline__ float bf2f(bf16_t b) { return __uint_as_float(((unsigned)b) << 16); }
__device__ __forceinline__ void unpack8(u32x4 v, float (&f)[8]) { f[0] = bflo(v.x); f[1] = bfhi(v.x); f[2] = bflo(v.y); f[3] = bfhi(v.y); f[4] = bflo(v.z); f[5] = bfhi(v.z); f[6] = bflo(v.w); f[7] = bfhi(v.w); }
__device__ __forceinline__ u32x4 pack8(const float (&f)[8]) { u32x4 o; o.x = pk2(f[0], f[1]); o.y = pk2(f[2], f[3]); o.z = pk2(f[4], f[5]); o.w = pk2(f[6], f[7]); return o; }
__device__ __forceinline__ float sigmoidf_(float x) { return __builtin_amdgcn_rcpf(1.f + __expf(-x)); }
__device__ __forceinline__ float siluf_(float x) { return x * sigmoidf_(x); }
__device__ __forceinline__ float wave_sum(float v) {
#pragma unroll
    for (int o = 1; o < 64; o <<= 1) v += __shfl_xor(v, o);
    return v;
}
__device__ __forceinline__ int get_tid() { int t = threadIdx.x; asm volatile("" : "+v"(t)); return t; }
__device__ __forceinline__ int get_bid() { int b = blockIdx.x; asm volatile("" : "+s"(b)); return b; }
__device__ __forceinline__ int get_nb() { int b = gridDim.x; asm volatile("" : "+s"(b)); return b; }
#define LDS_WAIT() asm volatile("s_waitcnt lgkmcnt(0)" ::: "memory")

template <int KSTEPS>
__device__ __forceinline__ f32x4 mma_k(const LAS bf16_t* A, int lda, int arow0, int ak0, const LAS bf16_t* B, int ldb, int brow0, int bk0, f32x4 acc, int lane) {
    const int r = lane & 15, q = lane >> 4;
    const LAS bf16_t* ap = A + (arow0 + r) * lda + ak0 + q * 8;
    const LAS bf16_t* bp = B + (brow0 + r) * ldb + bk0 + q * 8;
#pragma unroll
    for (int kk = 0; kk < KSTEPS; ++kk) {
        const bf16x8 a = *(const LAS bf16x8*)(ap + kk * 32), b = *(const LAS bf16x8*)(bp + kk * 32);
        acc = __builtin_amdgcn_mfma_f32_16x16x32_bf16(a, b, acc, 0, 0, 0);
    }
    return acc;
}


#define XB_TMO      128
#define XB_XCNT(j)  (256  + 64 * (j))
#define XB_XSUB(j)  (1280 + 64 * (j))
#define XB_XGEN(j)  (2304 + 64 * (j))
#define XB_TOP      3328
#define XB_TOPGEN   3392
#define XCD_BAR_WORDS 3456
#define XB_SPIN_CAP (1u << 20)
__device__ __forceinline__ unsigned xb_ld(unsigned* p)              { return __hip_atomic_load(p, __ATOMIC_RELAXED, __HIP_MEMORY_SCOPE_AGENT); }
__device__ __forceinline__ unsigned xb_add(unsigned* p, unsigned v) { return __hip_atomic_fetch_add(p, v, __ATOMIC_RELAXED, __HIP_MEMORY_SCOPE_AGENT); }
__device__ __forceinline__ unsigned xb_xcc_id() { return (unsigned)__builtin_amdgcn_s_getreg((3 << 11) | 20) & 0xFu; }
#define XB_SPIN(cond, bar) do { unsigned _sp = 0; while (cond) { __builtin_amdgcn_s_sleep(1); \
    if ((++_sp & 255u) == 0u) { if (xb_ld(&(bar)[XB_TMO])) break; if (_sp > XB_SPIN_CAP) { atomicAdd(&(bar)[XB_TMO], 1u); break; } } } } while (0)
__device__ __forceinline__ void xcd_barrier_complete(unsigned* bar, unsigned x, unsigned& nloc, unsigned& nx) {
    const unsigned G = gridDim.x;
    unsigned sum, cnt, mine, sp = 0u;
    for (;;) {
        sum = 0u; cnt = 0u; mine = 0u;
#pragma unroll
        for (unsigned j = 0; j < 16; ++j) { const unsigned c = xb_ld(&bar[XB_XCNT(j)]); sum += c; cnt += (c > 0u) ? 1u : 0u; mine = (j == x) ? c : mine; }
        if (sum == G) break;
        __builtin_amdgcn_s_sleep(1);
        if ((++sp & 255u) == 0u) { if (xb_ld(&bar[XB_TMO])) break; if (sp > XB_SPIN_CAP) { atomicAdd(&bar[XB_TMO], 1u); break; } }
    }
    nloc = mine > 0u ? mine : 1u; nx = cnt > 0u ? cnt : 1u;
}
__device__ __forceinline__ void xcd_barrier(unsigned* bar, volatile LAS unsigned* st) {
    asm volatile("s_waitcnt vmcnt(0)" ::: "memory");
    __syncthreads();
    if (threadIdx.x == 0) {
        __builtin_amdgcn_s_waitcnt(0);
        const unsigned x = xb_xcc_id();
        unsigned nloc = st[0], nx = st[1];
        if (nloc == 0u) { xcd_barrier_complete(bar, x, nloc, nx); st[0] = nloc; st[1] = nx; }
        const unsigned old = xb_add(&bar[XB_XSUB(x)], 1u);
        const unsigned gen = old / nloc;
        if (old + 1u == (gen + 1u) * nloc) {
            __builtin_amdgcn_fence(__ATOMIC_RELEASE, "agent");
            asm volatile("s_waitcnt vmcnt(0)" ::: "memory");
            const unsigned og = xb_add(&bar[XB_TOP], 1u);
            const unsigned tg = og / nx;
            if (og + 1u == (tg + 1u) * nx) xb_add(&bar[XB_TOPGEN], 1u);
            else XB_SPIN(xb_ld(&bar[XB_TOPGEN]) == tg, bar);
            __builtin_amdgcn_fence(__ATOMIC_ACQUIRE, "agent");
            xb_add(&bar[XB_XGEN(x)], 1u);
            asm volatile("s_waitcnt vmcnt(0)" ::: "memory");
        } else {
            XB_SPIN(xb_ld(&bar[XB_XGEN(x)]) == gen, bar);
            __builtin_amdgcn_fence(__ATOMIC_ACQUIRE, "agent");
            asm volatile("s_waitcnt vmcnt(0)" ::: "memory");
        }
    }
    __syncthreads();
}

namespace pg8 {
constexpr int BM = 256, BK = 64, HALF = 128, HTB = HALF * BK * 2, NXCD = 8, WGM = 8;
__device__ __forceinline__ int lds_byte(int r, int c) { const int st = (r >> 4) * 2 + (c >> 5), rr = r & 15, cc = c & 31, ob = rr * 64 + cc * 2; return st * 1024 + (ob ^ (((ob >> 9) & 1) << 5)); }
__device__ __forceinline__ void stage_rc(int b, int& R, int& C) { const int st = b / 1024, sb = b % 1024, swz = sb ^ (((sb >> 9) & 1) << 5); R = (st >> 1) * 16 + swz / 64; C = (st & 1) * 32 + (swz % 64) / 2; }
__device__ __forceinline__ int perm32(int rho) { const int n = rho >> 4, i = rho & 15; return 8 * (i >> 2) + 4 * n + (i & 3); }
struct Unit { int pm, pn, tag; };
struct Gemm { const bf16_t* A; const bf16_t* Bt; int K, lda, ldb; };
struct Sched {
    int nM, nN, nwg, G, c, mode; unsigned amul, bmul;
    __device__ __forceinline__ void init(int nM_, int nN_, int G_, int c_, int mode_, unsigned koff_) { nM = nM_; nN = nN_; nwg = nM * nN; G = G_; c = c_; mode = mode_; amul = (mode_ == 2 || mode_ == 3) ? 512u : koff_; bmul = (mode_ == 2) ? 524288u : (mode_ == 3 ? 0u : koff_); }
    __device__ __forceinline__ bool next(int i, Unit& u) const {
        if (mode == 2) {
            if (c >= 128 || i >= 4) return false;
            u.pm = c >> 2; u.pn = c & 3; u.tag = i; return true;
        }
        const long L = (long)i * G + c; if (L >= nwg) return false;
        int wgid = (int)L; { const int q = nwg / NXCD, r = nwg % NXCD, xcd = wgid % NXCD, off = wgid / NXCD; wgid = (xcd < r ? xcd * (q + 1) : r * (q + 1) + (xcd - r) * q) + off; }
        const int nig = WGM * nN, gid = wgid / nig, fm = gid * WGM, gsz = (nM - fm) < WGM ? (nM - fm) : WGM;
        u.pm = fm + ((wgid % nig) % gsz); const int pnx = (wgid % nig) / gsz;
        if (mode == 1) { u.pn = pnx & 3; u.tag = pnx >> 2; }
        else if (mode == 3) { u.pn = pnx; u.tag = pnx >> 2; }
        else { u.pn = pnx; u.tag = 0; }
        return true;
    }
};

template <class Epi>
__device__ __forceinline__ void gemm_phase(LAS unsigned char* lds, const Gemm g, const Sched& S, const Epi& E) {
    const int tid = get_tid(), wid = __builtin_amdgcn_readfirstlane(tid >> 6), lane = tid & 63, wr = wid >> 2, wc = wid & 3, fr = lane & 15, fq = lane >> 4;
    const int K = g.K, nt = K / BK;
    unsigned voffA[2], voffB[2];
#pragma unroll
    for (int i = 0; i < 2; ++i) { int R, C; stage_rc(tid * 16 + i * 8192, R, C); const int Rb = Epi::PERM ? ((R & ~31) + perm32(R & 31)) : R;
        voffA[i] = (unsigned)(R * g.lda + C) * 2u; voffB[i] = (unsigned)(Rb * g.ldb + C) * 2u; }
    const size_t kstep = (size_t)(BK * 2);
    const size_t hstepA = (size_t)HALF * g.lda * 2, hstepB = (size_t)HALF * g.ldb * 2;
    const size_t tstepA = 2 * hstepA, tstepB = 2 * hstepB;
    const unsigned ldsw = (unsigned)wid * 1024u;
    const int aoff = lds_byte(wr * 64 + fr, fq * 8), boff = lds_byte(wc * 32 + fr, fq * 8);
#define PG8_SA(b, h) (((b) * 2 + (h)) * HTB)
#define PG8_SB(b, h) ((4 + (b) * 2 + (h)) * HTB)
#define PG8_STAGE(bufoff, gbase, voff) do { _Pragma("unroll") for (int _i = 0; _i < 2; ++_i) \
        __builtin_amdgcn_global_load_lds((const unsigned*)((const char*)(gbase) + (voff)[_i]), (LAS unsigned*)(lds + (bufoff) + ldsw + _i * 8192), 16, 0, 0); } while (0)
#define PG8_LDA(dst, b, h) do { _Pragma("unroll") for (int m = 0; m < 4; ++m) _Pragma("unroll") for (int k = 0; k < 2; ++k) dst[m][k] = *(const LAS bf16x8*)(lds + PG8_SA(b, h) + aoff + m * 2048 + k * 1024); } while (0)
#define PG8_LDB(dst, b, h) do { _Pragma("unroll") for (int n = 0; n < 2; ++n) _Pragma("unroll") for (int k = 0; k < 2; ++k) dst[n][k] = *(const LAS bf16x8*)(lds + PG8_SB(b, h) + boff + n * 2048 + k * 1024); } while (0)
#define PG8_MMA(ai, bj, At, Bt) do { __builtin_amdgcn_s_setprio(1); _Pragma("unroll") for (int m = 0; m < 4; ++m) _Pragma("unroll") for (int n = 0; n < 2; ++n) _Pragma("unroll") for (int k = 0; k < 2; ++k) \
        acc[ai][bj][m][n] = __builtin_amdgcn_mfma_f32_16x16x32_bf16(Bt[n][k], At[m][k], acc[ai][bj][m][n], 0, 0, 0); __builtin_amdgcn_s_setprio(0); } while (0)
#define PG8_WAIT_V(n) asm volatile("s_waitcnt vmcnt(" #n ")" ::: "memory")
#define PG8_WAIT_L(n) asm volatile("s_waitcnt lgkmcnt(" #n ")" ::: "memory")
#define PG8_BAR __builtin_amdgcn_s_barrier()
#define PG8_SCHED __builtin_amdgcn_sched_barrier(0)
    Unit cur, nxt; int ui = 0;
    if (!S.next(0, cur)) return;
    f32x4 acc[2][2][4][2];
#pragma unroll
    for (int a = 0; a < 2; ++a)
#pragma unroll
        for (int b = 0; b < 2; ++b)
#pragma unroll
            for (int m = 0; m < 4; ++m)
#pragma unroll
                for (int n = 0; n < 2; ++n) acc[a][b][m][n] = (f32x4){0.f, 0.f, 0.f, 0.f};
    bf16x8 At[4][2], B0[2][2], B1[2][2];
    const char* cA = (const char*)g.A + (size_t)cur.pm * tstepA + (size_t)cur.tag * S.amul; const char* cB = (const char*)g.Bt + (size_t)cur.pn * tstepB + (size_t)cur.tag * S.bmul;
    PG8_STAGE(PG8_SB(0, 0), cB, voffB); PG8_STAGE(PG8_SB(0, 1), cB + hstepB, voffB); PG8_STAGE(PG8_SA(0, 0), cA, voffA); PG8_STAGE(PG8_SA(0, 1), cA + hstepA, voffA);
    if (wr == 1) PG8_BAR;
    PG8_WAIT_V(2); PG8_BAR;
    PG8_STAGE(PG8_SB(1, 0), cB + kstep, voffB); PG8_STAGE(PG8_SA(1, 0), cA + kstep, voffA); PG8_STAGE(PG8_SB(1, 1), cB + hstepB + kstep, voffB);
    PG8_WAIT_V(6); PG8_BAR;
    for (;;) {
        const bool has_next = S.next(ui + 1, nxt);
        const char* nA = has_next ? (const char*)g.A + (size_t)nxt.pm * tstepA + (size_t)nxt.tag * S.amul : cA; const char* nB = has_next ? (const char*)g.Bt + (size_t)nxt.pn * tstepB + (size_t)nxt.tag * S.bmul : cB;
        for (int t = 0; t < nt; t += 2) {
            const bool last = (t == nt - 2);
            const char* a1 = cA + (size_t)(t + 1) * kstep;
            const char* a2 = last ? nA : cA + (size_t)(t + 2) * kstep; const char* b2 = last ? nB : cB + (size_t)(t + 2) * kstep;
            const char* a3 = a2 + kstep; const char* b3 = b2 + kstep;
            PG8_LDB(B0, 0, 0); PG8_LDB(B1, 0, 1); PG8_SCHED; PG8_LDA(At, 0, 0); PG8_STAGE(PG8_SA(1, 1), a1 + hstepA, voffA);
            PG8_WAIT_V(8); PG8_WAIT_L(0); PG8_BAR; PG8_MMA(0, 0, At, B0); PG8_MMA(0, 1, At, B1); PG8_BAR; PG8_SCHED;
            PG8_LDA(At, 0, 1); PG8_STAGE(PG8_SB(0, 0), b2, voffB); PG8_STAGE(PG8_SB(0, 1), b2 + hstepB, voffB); PG8_STAGE(PG8_SA(0, 0), a2, voffA);
            PG8_WAIT_V(8); PG8_WAIT_L(0); PG8_BAR; PG8_MMA(1, 0, At, B0); PG8_MMA(1, 1, At, B1); PG8_BAR; PG8_SCHED;
            PG8_LDB(B0, 1, 0); PG8_LDB(B1, 1, 1); PG8_SCHED; PG8_LDA(At, 1, 0); PG8_STAGE(PG8_SA(0, 1), a2 + hstepA, voffA);
            PG8_WAIT_V(8); PG8_WAIT_L(0); PG8_BAR; PG8_MMA(0, 0, At, B0); PG8_MMA(0, 1, At, B1); PG8_BAR; PG8_SCHED;
            PG8_LDA(At, 1, 1); PG8_STAGE(PG8_SB(1, 0), b3, voffB); PG8_STAGE(PG8_SB(1, 1), b3 + hstepB, voffB); PG8_STAGE(PG8_SA(1, 0), a3, voffA);
            PG8_WAIT_V(8); PG8_WAIT_L(0); PG8_BAR; PG8_MMA(1, 0, At, B0); PG8_MMA(1, 1, At, B1); PG8_BAR; PG8_SCHED;
        }
        if (wr == 0) PG8_BAR;
        E(acc, cur, wr, wc, fr, fq);
        if (!has_next) break;
#pragma unroll
        for (int a = 0; a < 2; ++a)
#pragma unroll
            for (int b = 0; b < 2; ++b)
#pragma unroll
                for (int m = 0; m < 4; ++m)
#pragma unroll
                    for (int n = 0; n < 2; ++n) acc[a][b][m][n] = (f32x4){0.f, 0.f, 0.f, 0.f};
        cur = nxt; cA = nA; cB = nB; ++ui;
        if (wr == 1) PG8_BAR;
    }
    PG8_WAIT_V(0);
    PG8_BAR;
#undef PG8_SA
#undef PG8_SB
#undef PG8_STAGE
#undef PG8_LDA
#undef PG8_LDB
#undef PG8_MMA
#undef PG8_WAIT_V
#undef PG8_WAIT_L
#undef PG8_BAR
#undef PG8_SCHED
}

struct Epi {
    static constexpr bool PERM = true;
    int mode, l; bf16_t* o16; bf16_t* g16; float* f32; const float* bias; float* nak; float* nav;
    __device__ __forceinline__ void operator()(const f32x4 (&acc)[2][2][4][2], const Unit& u, int wr, int wc, int fr, int fq) const {
        const int row0 = u.pm * BM + wr * 64 + fr, colt = wc * 32 + 8 * fq;
        const bool gate_tile = (mode == 0) && (u.pn >= 12);
        f32x4 bv[2][2];
#pragma unroll
        for (int bj = 0; bj < 2; ++bj)
#pragma unroll
            for (int n = 0; n < 2; ++n) bv[bj][n] = gate_tile ? *(const f32x4*)(bias + (u.pn - 12) * BM + colt + bj * HALF + 4 * n) : (f32x4){0.f, 0.f, 0.f, 0.f};
        const bool wna = (mode == 0) && (u.pn == 9 || u.pn == 10) && u.pm < 16;
        float* nbase = nak + ((u.pn == 9) ? (ptrdiff_t)0 : (nav - nak));
#pragma unroll
        for (int ai = 0; ai < 2; ++ai)
#pragma unroll
            for (int m = 0; m < 4; ++m) { const int row = row0 + ai * HALF + m * 16;
#pragma unroll
                for (int bj = 0; bj < 2; ++bj) {
                    f32x4 v0 = acc[ai][bj][m][0], v1 = acc[ai][bj][m][1];
                    const int ct = colt + bj * HALF;
                    if (mode == 2) { bf16_t* d = (bf16_t*)f32 + (size_t)u.tag * ((size_t)T_ALL * DM) + (size_t)row * DM + u.pn * BM + ct;
                        u32x4 w; w.x = pk2(v0[0], v0[1]); w.y = pk2(v0[2], v0[3]); w.z = pk2(v1[0], v1[1]); w.w = pk2(v1[2], v1[3]); *(u32x4*)d = w; continue; }
                    size_t oidx;
                    if (mode == 0) {
                        if (gate_tile) { v0 += bv[bj][0]; v1 += bv[bj][1];
#pragma unroll
                            for (int j = 0; j < 4; ++j) { v0[j] = sigmoidf_(v0[j]); v1[j] = sigmoidf_(v1[j]); }
                            oidx = (size_t)row * NGATE + (u.pn - 12) * BM + ct;
                        } else {
                            oidx = (size_t)row * NPROJ + u.pn * BM + ct;
                            if (wna) { float* d = nbase + ((size_t)((u.pm * 4 + l) * 256 + (row & 255)) * 256 + ct); *(f32x4*)d = v0; *(f32x4*)(d + 4) = v1; }
                        }
                    } else {
                        if (mode == 3) {
#pragma unroll
                        for (int j = 0; j < 4; ++j) { const float a = fmaxf(v0[j], 0.f), b = fmaxf(v1[j], 0.f); v0[j] = a * a; v1[j] = b * b; } }
                        oidx = (size_t)row * DFF + u.pn * BM + ct;
                    }
                    u32x4 w; w.x = pk2(v0[0], v0[1]); w.y = pk2(v0[2], v0[3]); w.z = pk2(v1[0], v1[1]); w.w = pk2(v1[2], v1[3]);
                    const ptrdiff_t gdelta = g16 - o16;
                    *(u32x4*)(o16 + (oidx + (gate_tile ? gdelta : (ptrdiff_t)0))) = w;
                }
                asm volatile("" ::: "memory"); }
    }
};
}

__device__ __forceinline__ void transpose_item(const float* W, int N, bf16_t* WT, int ldk, int dstrow0, int k0, int n0, LAS float* scr, int lane) {
#pragma unroll 8
    for (int i = 0; i < 32; ++i) { const int kk = 2 * i + (lane >> 5); scr[kk * 33 + (lane & 31)] = W[(size_t)(k0 + kk) * N + n0 + (lane & 31)]; }
    LDS_WAIT();
    const int c = lane & 7;
#pragma unroll
    for (int j = 0; j < 4; ++j) { const int n = (lane >> 3) + 8 * j; const LAS float* s = scr + (8 * c) * 33 + n;
        u32x4 o; o.x = pk2(s[0 * 33], s[1 * 33]); o.y = pk2(s[2 * 33], s[3 * 33]); o.z = pk2(s[4 * 33], s[5 * 33]); o.w = pk2(s[6 * 33], s[7 * 33]);
        *(u32x4*)(WT + (size_t)(dstrow0 + n) * ldk + k0 + 8 * c) = o; }
    LDS_WAIT();
}

__device__ __forceinline__ void phase0(const Params& p, LAS unsigned char* lds) {
    const int tid = get_tid(), lane = tid & 63, wave = tid >> 6;
    const int G = get_nb();
    if (get_bid() == 0 && tid < N_IN) ((const float**)(p.ws + WS_TAB))[tid] = p.in[tid];
    {
        LAS float* svec = (LAS float*)lds;
        LAS float* red = (LAS float*)(lds + 20480);
        bool have = false;
        for (int it = get_bid(); it < 384; it += G) {
            if (!have) {
                for (int i = tid; i < 5 * 1024; i += 512) { const int j = i >> 10, k = i & 1023; const float v = (j == 0) ? PIN(I_CCTX)[k] : PIN(I_C)[(j - 1) * 1024 + k]; svec[i] = siluf_(v); }
                __syncthreads(); have = true;
            }
            const int l = it / 96, cch = it % 96, cq = tid & 15, ks = tid >> 4, col = cch * 64 + cq * 4;
            f32x4 a0 = {0, 0, 0, 0}, a1 = a0, a2 = a0, a3 = a0, a4 = a0;
            const float* wp = PIN(I_WADA) + ((size_t)l * 1024 + ks * 32) * 6144 + col;
#pragma unroll 4
            for (int k = 0; k < 32; ++k) { const f32x4 w = *(const f32x4*)(wp + (size_t)k * 6144); const int kk = ks * 32 + k;
                a0 += svec[kk] * w; a1 += svec[1024 + kk] * w; a2 += svec[2048 + kk] * w; a3 += svec[3072 + kk] * w; a4 += svec[4096 + kk] * w; }
            LAS float* rp = red + ks * 320 + cq * 4;
#pragma unroll
            for (int e = 0; e < 4; ++e) { rp[e] = a0[e]; rp[64 + e] = a1[e]; rp[128 + e] = a2[e]; rp[192 + e] = a3[e]; rp[256 + e] = a4[e]; }
            __syncthreads();
            if (tid < 320) { float s = 0.f;
#pragma unroll 8
                for (int k = 0; k < 32; ++k) s += red[k * 320 + tid];
                const int j = tid >> 6, cc = tid & 63;
                ((float*)(p.ws + WS_MOD))[(size_t)(l * 5 + j) * 6144 + cch * 64 + cc] = s + PIN(I_BADA)[l * 6144 + cch * 64 + cc]; }
            __syncthreads();
        }
        __syncthreads();
    }
    {
        LAS float* scr = (LAS float*)(lds + wave * 8448);
        const int gw = get_bid() * 8 + wave, NGW = G * 8;
        constexpr int I_IN = 16 * 89, I_MG = 16 * 128, I_BRN = 4 * 32, I_BR = 4 * I_BRN, I_OUT = 16 * 32, I_M1 = 16 * 128, I_M2 = 64 * 32, I_GLU = 4 * 16;
        constexpr int I_LAYER = I_IN + I_MG + I_BR + I_OUT + I_M1 + I_M2 + I_GLU;
        for (int it = gw; it < 4 * I_LAYER; it += NGW) {
            const int l = it / I_LAYER; int r = it % I_LAYER;
            unsigned char* wl = p.ws + WS_W + (size_t)l * WL_STRIDE;
            if (r < I_IN) { const int kb = r / 89, nb = r % 89, n0 = nb * 32; const int dr = (n0 < 2048) ? n0 : (n0 == 2048 ? C_GLR : n0 - 32);
                transpose_item(PIN(I_WIN) + (size_t)l * 1024 * 2848, 2848, (bf16_t*)(wl + WL_CAT), 1024, dr, kb * 64, n0, scr, lane); continue; } r -= I_IN;
            if (r < I_MG) { const int kb = r / 128, nb = r % 128;
                transpose_item(PIN(I_WMG) + (size_t)l * 1024 * 4096, 4096, (bf16_t*)(wl + WL_CAT), 1024, 3072 + nb * 32, kb * 64, nb * 32, scr, lane); continue; } r -= I_MG;
            if (r < I_BR) { const int n = r / I_BRN, rr = r % I_BRN, kb = rr / 32, nb = rr % 32;
                transpose_item(PIN(I_WBR) + ((size_t)l * 4 + n) * 256 * 1024, 1024, (bf16_t*)(wl + WL_BR), 256, n * 1024 + nb * 32, kb * 64, nb * 32, scr, lane); continue; } r -= I_BR;
            if (r < I_OUT) { const int kb = r / 32, nb = r % 32;
                transpose_item(PIN(I_WOUT) + (size_t)l * 1024 * 1024, 1024, (bf16_t*)(wl + WL_OUT), 1024, nb * 32, kb * 64, nb * 32, scr, lane); continue; } r -= I_OUT;
            if (r < I_M1) { const int kb = r / 128, nb = r % 128;
                transpose_item(PIN(I_W1) + (size_t)l * 1024 * 4096, 4096, (bf16_t*)(wl + WL_M1), 1024, nb * 32, kb * 64, nb * 32, scr, lane); continue; } r -= I_M1;
            if (r < I_M2) { const int kb = r / 32, nb = r % 32;
                transpose_item(PIN(I_W2) + (size_t)l * 4096 * 1024, 1024, (bf16_t*)(wl + WL_M2), 4096, nb * 32, kb * 64, nb * 32, scr, lane); continue; } r -= I_M2;
            { const int kb = r / 16, nb = r % 16;
                transpose_item(PIN(I_S5WG) + (size_t)l * 256 * 512, 512, (bf16_t*)(wl + WL_GLU), 256, nb * 32, kb * 64, nb * 32, scr, lane); }
        }
        const int gt = get_bid() * 512 + tid, NT = G * 512;
        for (int i = gt; i < 4 * 28672; i += NT) { const int l = i / 28672, o = i % 28672;
            *(u32x4*)(p.ws + WS_W + (size_t)l * WL_STRIDE + WL_CAT + (size_t)2848 * 2048 + (size_t)o * 16) = (u32x4){0u, 0u, 0u, 0u}; }
    }
}

__device__ __forceinline__ void row_phase(const Ctx& p, int l, int mode) {
    const int tid = get_tid(), lane = tid & 63, wave = tid >> 6;
    const int gw = get_bid() * 8 + wave, NGW = get_nb() * 8;
    float* xbuf = p.out + O_X;
    const bf16_t* part = (const bf16_t*)(p.ws + WS_PART);
    const float* mod = (const float*)(p.ws + WS_MOD);
    bf16_t* H = (bf16_t*)(p.ws + WS_H);
    for (int row = gw; row < T_ALL; row += NGW) {
        const int mj = (row < T_CTX) ? 0 : 1 + ((row - T_CTX) >> 10);
        f32x4 x[4];
        if (mode == 0 && l == 0) {
            const float* src = (row < T_CTX) ? PIN(I_XP) + (size_t)row * DM : PIN(I_XS) + (size_t)(row - T_CTX) * DM;
#pragma unroll
            for (int j = 0; j < 4; ++j) x[j] = *(const f32x4*)(src + 256 * j + 4 * lane);
        } else {
            const int lp = (mode == 0) ? l - 1 : l, np = (mode == 0) ? 3 : 1, gsl = (mode == 0) ? 5 : 2;
            f32x4 f[4]; float ss = 0.f;
#pragma unroll
            for (int j = 0; j < 4; ++j) { const u32x2 pa = *(const u32x2*)(part + (size_t)row * DM + 256 * j + 4 * lane), pb = *(const u32x2*)(part + (size_t)(T_ALL + row) * DM + 256 * j + 4 * lane);
                f[j] = (f32x4){bflo(pa.x) + bflo(pb.x), bfhi(pa.x) + bfhi(pb.x), bflo(pa.y) + bflo(pb.y), bfhi(pa.y) + bfhi(pb.y)};
                ss += (f[j][0] * f[j][0] + f[j][1] * f[j][1]) + (f[j][2] * f[j][2] + f[j][3] * f[j][3]); }
            const float rstd = rsqrtf(wave_sum(ss) * (1.f / DM) + EPS);
#pragma unroll
            for (int j = 0; j < 4; ++j) { const int col = 256 * j + 4 * lane;
                const f32x4 gn = *(const f32x4*)(PIN(I_GN) + (size_t)(lp * 4 + np) * DM + col);
                const f32x4 gt = *(const f32x4*)(mod + (size_t)(lp * 5 + mj) * 6144 + gsl * DM + col);
                x[j] = *(const f32x4*)(xbuf + (size_t)row * DM + col) + gt * (f[j] * rstd * gn); }
        }
#pragma unroll
        for (int j = 0; j < 4; ++j) *(f32x4*)(xbuf + (size_t)row * DM + 256 * j + 4 * lane) = x[j];
        if (!(mode == 0 && l == 4)) {
            float ss = 0.f;
#pragma unroll
            for (int j = 0; j < 4; ++j) ss += (x[j][0] * x[j][0] + x[j][1] * x[j][1]) + (x[j][2] * x[j][2] + x[j][3] * x[j][3]);
            const float rstd = rsqrtf(wave_sum(ss) * (1.f / DM) + EPS);
            const int nh = (mode == 0) ? 0 : 2, shs = (mode == 0) ? 0 : 3, scs = (mode == 0) ? 1 : 4;
#pragma unroll
            for (int j = 0; j < 4; ++j) { const int col = 256 * j + 4 * lane;
                const f32x4 gn = *(const f32x4*)(PIN(I_GN) + (size_t)(l * 4 + nh) * DM + col);
                const f32x4 sh = *(const f32x4*)(mod + (size_t)(l * 5 + mj) * 6144 + shs * DM + col);
                const f32x4 sc = *(const f32x4*)(mod + (size_t)(l * 5 + mj) * 6144 + scs * DM + col);
                const f32x4 hv = (x[j] * rstd * gn) * (1.f + sc) + sh;
                u32x2 o; o.x = pk2(hv[0], hv[1]); o.y = pk2(hv[2], hv[3]);
                *(u32x2*)(H + (size_t)row * DM + col) = o; }
        }
    }
}

__device__ __forceinline__ void rope8(const float (&x)[8], const float (&xp)[8], int d0, int s, float (&o)[8]) {
    const float pos = (float)((d0 < 32) ? (s >> 6) : (s & 63));
    const float sgn = (d0 & 16) ? 1.f : -1.f;
#pragma unroll
    for (int e = 0; e < 8; ++e) { const int f = (d0 & 15) + e; const float ang = pos * exp2f(-0.8304820237f * (float)f);
        float sn, cs; __sincosf(ang, &sn, &cs); o[e] = x[e] * cs + sgn * xp[e] * sn; }
}
__device__ __forceinline__ void load_qk8(const bf16_t* proj, int t, int colbase, int d0, bool rope, int s, float (&o)[8]) {
    const bf16_t* rowp = proj + (size_t)t * NPROJ + colbase;
    float x[8]; unpack8(*(const u32x4*)(rowp + d0), x);
    if (!rope) {
#pragma unroll
        for (int e = 0; e < 8; ++e) o[e] = x[e];
        return;
    }
    float xp[8]; unpack8(*(const u32x4*)(rowp + (d0 ^ 16)), xp);
    rope8(x, xp, d0, s, o);
}

__device__ __forceinline__ int ret_sidx(int path, int b, int h, int dir, int c) { return path ? 512 + ((b * 4 + h) * 2 + dir) * 16 + c : ((b * 4 + h) * 2 + dir) * 4 + c; }

__device__ __forceinline__ void ret_state_item(const Ctx& p, int l, int path, int b, int h, int dir, LAS unsigned char* lds) {
    const int tid = get_tid(), lane = tid & 63, w = tid >> 6, r = lane & 15, q = lane >> 4;
    LAS bf16_t* KdT0 = (LAS bf16_t*)lds; LAS bf16_t* VT0 = KdT0 + 2 * 64 * 72;
    const bf16_t* proj = (const bf16_t*)(p.ws + WS_PROJ);
    bf16_t* rets = (bf16_t*)(p.ws + WS_RETS);
    const int nch = path ? 16 : 4, tok0 = path ? T_CTX + b * 1024 : b * 256;
    const float lg = PIN(I_RLD)[(l * 2 + dir) * 4 + h], cdec = __expf(lg * 64.f);
    const int rb = w >> 1, cb0 = (w & 1) * 2;
    f32x4 acc[2];
#pragma unroll
    for (int i = 0; i < 2; ++i)
#pragma unroll
        for (int e = 0; e < 4; ++e) { const int dv = rb * 16 + q * 4 + e, dk = (cb0 + i) * 16 + r;
            acc[i][e] = path ? PIN(I_SRET)[((size_t)(((b * 4 + l) * 2 + dir) * 4 + h) * 64 + dk) * 64 + dv] : 0.f; }
    const int j = tid >> 3, d0 = (tid & 7) * 8;
    u32x4 kraw, kpar, vraw;
    { const int c0 = dir ? nch - 1 : 0; const bf16_t* rp = proj + (size_t)(tok0 + c0 * 64 + j) * NPROJ + h * 64;
      kraw = *(const u32x4*)(rp + C_RK + d0); kpar = *(const u32x4*)(rp + C_RK + (d0 ^ 16)); vraw = *(const u32x4*)(rp + C_RV + d0); }
    for (int ci = 0; ci < nch; ++ci) {
        const int c = dir ? nch - 1 - ci : ci;
        bf16_t* sd = rets + (size_t)ret_sidx(path, b, h, dir, c) * 4096;
#pragma unroll
        for (int i = 0; i < 2; ++i)
#pragma unroll
            for (int e = 0; e < 4; ++e) sd[(rb * 16 + q * 4 + e) * 64 + (cb0 + i) * 16 + r] = f2bf(acc[i][e]);
        const int s = c * 64 + j;
        float kx[8], kp[8], kv[8], vv[8];
        unpack8(kraw, kx); unpack8(kpar, kp); unpack8(vraw, vv);
        if (path) rope8(kx, kp, d0, s, kv); else {
#pragma unroll
            for (int e = 0; e < 8; ++e) kv[e] = kx[e]; }
        if (ci + 1 < nch) { const int cn = dir ? nch - 2 - ci : ci + 1; const bf16_t* rp = proj + (size_t)(tok0 + cn * 64 + j) * NPROJ + h * 64;
            kraw = *(const u32x4*)(rp + C_RK + d0); kpar = *(const u32x4*)(rp + C_RK + (d0 ^ 16)); vraw = *(const u32x4*)(rp + C_RV + d0); }
        const float wj = 0.125f * __expf(lg * (float)(dir ? j : 63 - j));
        LAS bf16_t* KdT = KdT0 + (ci & 1) * (64 * 72); LAS bf16_t* VT = VT0 + (ci & 1) * (64 * 72);
#pragma unroll
        for (int e = 0; e < 8; ++e) { KdT[(d0 + e) * 72 + j] = f2bf(kv[e] * wj); VT[(d0 + e) * 72 + j] = f2bf(vv[e]); }
        __syncthreads();
#pragma unroll
        for (int i = 0; i < 2; ++i) { acc[i] *= cdec; acc[i] = mma_k<2>(VT, 72, rb * 16, 0, KdT, 72, (cb0 + i) * 16, 0, acc[i], lane); }
    }
    __syncthreads();
    if (!path) {
#pragma unroll
        for (int i = 0; i < 2; ++i)
#pragma unroll
            for (int e = 0; e < 4; ++e) { const int dv = rb * 16 + q * 4 + e, dk = (cb0 + i) * 16 + r;
                p.out[O_RET + ((size_t)(((b * 4 + l) * 2 + dir) * 4 + h) * 64 + dk) * 64 + dv] = acc[i][e]; }
    }
}

__device__ __forceinline__ void headnorm_store(const LAS float* O, const float* gn, const bf16_t* gaterow, bf16_t* dst, int tid) {
    const int i = tid >> 3, sub = tid & 7;
    float v[8]; float s = 0.f;
#pragma unroll
    for (int e = 0; e < 8; ++e) { v[e] = O[i * 65 + sub * 8 + e]; s += v[e]; }
    s += __shfl_xor(s, 1); s += __shfl_xor(s, 2); s += __shfl_xor(s, 4);
    const float mu = s * (1.f / 64.f); float qv = 0.f;
#pragma unroll
    for (int e = 0; e < 8; ++e) { v[e] -= mu; qv += v[e] * v[e]; }
    qv += __shfl_xor(qv, 1); qv += __shfl_xor(qv, 2); qv += __shfl_xor(qv, 4);
    const float rstd = rsqrtf(qv * (1.f / 64.f) + EPS);
    float g[8]; unpack8(*(const u32x4*)(gaterow + sub * 8), g);
    float o[8];
#pragma unroll
    for (int e = 0; e < 8; ++e) o[e] = v[e] * rstd * gn[sub * 8 + e] * siluf_(g[e]);
    *(u32x4*)(dst + sub * 8) = pack8(o);
}

__device__ __forceinline__ void ret_out_item(const Ctx& p, int l, int path, int b, int h, int c, LAS unsigned char* lds) {
    const int tid = get_tid(), lane = tid & 63, w = tid >> 6, r = lane & 15, q = lane >> 4;
    LAS bf16_t* Q = (LAS bf16_t*)lds; LAS bf16_t* Kk = Q + 64 * 72; LAS bf16_t* VT = Kk + 64 * 72; LAS bf16_t* P = VT + 64 * 72;
    LAS bf16_t* QD = P + 64 * 72; LAS bf16_t* ST = QD + 64 * 136; LAS float* O = (LAS float*)(ST + 64 * 136);
    const bf16_t* proj = (const bf16_t*)(p.ws + WS_PROJ);
    const bf16_t* rets = (const bf16_t*)(p.ws + WS_RETS);
    const int tok0 = path ? T_CTX + b * 1024 : b * 256;
    const float lgf = PIN(I_RLD)[(l * 2 + 0) * 4 + h], lgb = PIN(I_RLD)[(l * 2 + 1) * 4 + h];
    {
        const int j = tid >> 3, d0 = (tid & 7) * 8, s = c * 64 + j, t = tok0 + s;
        float qv[8], kv[8], vv[8];
        load_qk8(proj, t, C_RQ + h * 64, d0, path != 0, s, qv);
        load_qk8(proj, t, C_RK + h * 64, d0, path != 0, s, kv);
        unpack8(*(const u32x4*)(proj + (size_t)t * NPROJ + C_RV + h * 64 + d0), vv);
        const float qf = __expf(lgf * (float)(j + 1)), qb = __expf(lgb * (float)(64 - j));
        float t0[8], t1[8], t2[8];
#pragma unroll
        for (int e = 0; e < 8; ++e) { kv[e] *= 0.125f; t0[e] = qv[e] * qf; t1[e] = qv[e] * qb; t2[e] = vv[e]; }
        *(LAS u32x4*)(Q + j * 72 + d0) = pack8(qv);
        *(LAS u32x4*)(Kk + j * 72 + d0) = pack8(kv);
        *(LAS u32x4*)(QD + j * 136 + d0) = pack8(t0);
        *(LAS u32x4*)(QD + j * 136 + 64 + d0) = pack8(t1);
#pragma unroll
        for (int e = 0; e < 8; ++e) VT[(d0 + e) * 72 + j] = f2bf(t2[e]);
        const u32x4 sf = *(const u32x4*)(rets + (size_t)ret_sidx(path, b, h, 0, c) * 4096 + tid * 8);
        const u32x4 sb = *(const u32x4*)(rets + (size_t)ret_sidx(path, b, h, 1, c) * 4096 + tid * 8);
        *(LAS u32x4*)(ST + j * 136 + d0) = sf;
        *(LAS u32x4*)(ST + j * 136 + 64 + d0) = sb;
    }
    __syncthreads();
    const int rb = w >> 1, cb0 = (w & 1) * 2;
#pragma unroll
    for (int i = 0; i < 2; ++i) {
        f32x4 a = {0.f, 0.f, 0.f, 0.f};
        a = mma_k<2>(Q, 72, rb * 16, 0, Kk, 72, (cb0 + i) * 16, 0, a, lane);
#pragma unroll
        for (int e = 0; e < 4; ++e) { const int ii = rb * 16 + q * 4 + e, jj = (cb0 + i) * 16 + r;
            float wgt = 0.f;
            if (jj <= ii) wgt += __expf(lgf * (float)(ii - jj));
            if (jj >= ii) wgt += __expf(lgb * (float)(jj - ii));
            P[ii * 72 + jj] = f2bf(a[e] * wgt); }
    }
    __syncthreads();
#pragma unroll
    for (int i = 0; i < 2; ++i) {
        f32x4 a = {0.f, 0.f, 0.f, 0.f};
        a = mma_k<2>(P, 72, rb * 16, 0, VT, 72, (cb0 + i) * 16, 0, a, lane);
        a = mma_k<4>(QD, 136, rb * 16, 0, ST, 136, (cb0 + i) * 16, 0, a, lane);
#pragma unroll
        for (int e = 0; e < 4; ++e) O[(rb * 16 + q * 4 + e) * 65 + (cb0 + i) * 16 + r] = a[e];
    }
    __syncthreads();
    {
        const int i = tid >> 3, t = tok0 + c * 64 + i;
        headnorm_store(O, PIN(I_RGN) + l * 256 + h * 64, proj + (size_t)t * NPROJ + C_RG + h * 64, (bf16_t*)(p.ws + WS_BR) + (size_t)t * DM + 0 * 256 + h * 64, tid);
    }
    __syncthreads();
}

__device__ __forceinline__ void gla_cum(const Ctx& p, int l, int dir, int h, u32x4 lra, u32x4 lrb, LAS float* Bc, LAS float* BEND) {
    const int tid = get_tid(), lane = tid & 63, w = tid >> 6;
    {
        const int j = tid >> 3, dd = (tid & 7) * 4;
        float lr[16]; { float a[8], b2[8]; unpack8(lra, a); unpack8(lrb, b2);
#pragma unroll
            for (int e = 0; e < 8; ++e) { lr[e] = a[e]; lr[8 + e] = b2[e]; } }
        const float* wg = PIN(I_GWG) + (size_t)(l * 2 + dir) * 16 * 128 + h * 32 + dd;
        f32x4 z = *(const f32x4*)(PIN(I_GBG) + (l * 2 + dir) * 128 + h * 32 + dd);
#pragma unroll
        for (int rr = 0; rr < 16; ++rr) z += lr[rr] * *(const f32x4*)(wg + rr * 128);
#pragma unroll
        for (int e = 0; e < 4; ++e) { const float x = z[e]; const float ls = fminf(x, 0.f) - __logf(1.f + __expf(-fabsf(x))); Bc[j * 33 + dd + e] = ls * (1.f / 16.f); }
    }
    __syncthreads();
    {
        const int pos = dir ? 63 - lane : lane;
#pragma unroll
        for (int k = 0; k < 4; ++k) { const int d = w * 4 + k; float v = Bc[pos * 33 + d];
#pragma unroll
            for (int off = 1; off < 64; off <<= 1) { const float tv = __shfl_up(v, off); if (lane >= off) v += tv; }
            Bc[pos * 33 + d] = v; if (lane == 63) BEND[d] = v; }
    }
    __syncthreads();
}

__device__ __forceinline__ int gla_sidx(int path, int b, int h, int dir, int c) { return ret_sidx(path, b, h, dir, c); }

__device__ __forceinline__ void gla_state_item(const Ctx& p, int l, int path, int b, int h, int dir, LAS unsigned char* lds) {
    const int tid = get_tid(), lane = tid & 63, w = tid >> 6, r = lane & 15, q = lane >> 4;
    LAS bf16_t* KdT0 = (LAS bf16_t*)lds; LAS bf16_t* VT0 = KdT0 + 2 * 32 * 72; LAS float* Bc0 = (LAS float*)(VT0 + 2 * 64 * 72); LAS float* BEND0 = Bc0 + 2 * 64 * 33;
    const bf16_t* proj = (const bf16_t*)(p.ws + WS_PROJ);
    bf16_t* glas = (bf16_t*)(p.ws + WS_GLAS);
    const int nch = path ? 16 : 4, tok0 = path ? T_CTX + b * 1024 : b * 256;
    const int rb = w >> 1, cb = w & 1;
    f32x4 acc;
#pragma unroll
    for (int e = 0; e < 4; ++e) { const int dv = rb * 16 + q * 4 + e, dk = cb * 16 + r;
        acc[e] = path ? PIN(I_SGLA)[((size_t)(((b * 4 + l) * 2 + dir) * 4 + h) * 32 + dk) * 64 + dv] : 0.f; }
    const int j = tid >> 3, dd = (tid & 7) * 4, d0 = (tid & 7) * 8;
    u32x4 lra, lrb, vraw; u32x2 kw;
    { const int c0 = dir ? nch - 1 : 0; const bf16_t* rp = proj + (size_t)(tok0 + c0 * 64 + j) * NPROJ;
      lra = *(const u32x4*)(rp + C_GLR + dir * 16); lrb = *(const u32x4*)(rp + C_GLR + dir * 16 + 8); kw = *(const u32x2*)(rp + C_GK + h * 32 + dd); vraw = *(const u32x4*)(rp + C_GV + h * 64 + d0); }
    for (int ci = 0; ci < nch; ++ci) {
        const int c = dir ? nch - 1 - ci : ci;
        LAS bf16_t* KdT = KdT0 + (ci & 1) * (32 * 72); LAS bf16_t* VT = VT0 + (ci & 1) * (64 * 72); LAS float* Bc = Bc0 + (ci & 1) * (64 * 33); LAS float* BEND = BEND0 + (ci & 1) * 32;
        gla_cum(p, l, dir, h, lra, lrb, Bc, BEND);
        bf16_t* sd = glas + (size_t)gla_sidx(path, b, h, dir, c) * 2048;
#pragma unroll
        for (int e = 0; e < 4; ++e) sd[(rb * 16 + q * 4 + e) * 32 + cb * 16 + r] = f2bf(acc[e]);
        {
            const float kf[4] = {bflo(kw.x), bfhi(kw.x), bflo(kw.y), bfhi(kw.y)};
#pragma unroll
            for (int e = 0; e < 4; ++e) KdT[(dd + e) * 72 + j] = f2bf(kf[e] * __expf(BEND[dd + e] - Bc[j * 33 + dd + e]));
            float vv[8]; unpack8(vraw, vv);
#pragma unroll
            for (int e = 0; e < 8; ++e) VT[(d0 + e) * 72 + j] = f2bf(vv[e]);
        }
        if (ci + 1 < nch) { const int cn = dir ? nch - 2 - ci : ci + 1; const bf16_t* rp = proj + (size_t)(tok0 + cn * 64 + j) * NPROJ;
            lra = *(const u32x4*)(rp + C_GLR + dir * 16); lrb = *(const u32x4*)(rp + C_GLR + dir * 16 + 8); kw = *(const u32x2*)(rp + C_GK + h * 32 + dd); vraw = *(const u32x4*)(rp + C_GV + h * 64 + d0); }
        __syncthreads();
        acc *= __expf(BEND[cb * 16 + r]);
        acc = mma_k<2>(VT, 72, rb * 16, 0, KdT, 72, cb * 16, 0, acc, lane);
    }
    __syncthreads();
    if (!path) {
#pragma unroll
        for (int e = 0; e < 4; ++e) { const int dv = rb * 16 + q * 4 + e, dk = cb * 16 + r;
            p.out[O_GLA + ((size_t)(((b * 4 + l) * 2 + dir) * 4 + h) * 32 + dk) * 64 + dv] = acc[e]; }
    }
}

__device__ __forceinline__ void gla_out_item(const Ctx& p, int l, int path, int b, int h, int c, LAS unsigned char* lds) {
    const int tid = get_tid(), lane = tid & 63, w = tid >> 6, r = lane & 15, q = lane >> 4;
    LAS bf16_t* QD = (LAS bf16_t*)lds; LAS bf16_t* KD = QD + 64 * 72; LAS bf16_t* VT = KD + 64 * 72; LAS bf16_t* P = VT + 64 * 72; LAS bf16_t* ST = P + 64 * 72;
    LAS float* O = (LAS float*)(ST + 64 * 72); LAS float* BcF = O + 64 * 65; LAS float* BcB = BcF + 64 * 33; LAS float* BEND = BcB + 64 * 33;
    const bf16_t* proj = (const bf16_t*)(p.ws + WS_PROJ);
    const bf16_t* glas = (const bf16_t*)(p.ws + WS_GLAS);
    const int tok0 = path ? T_CTX + b * 1024 : b * 256, tc0 = tok0 + c * 64;
    { const bf16_t* rp = proj + (size_t)(tc0 + (tid >> 3)) * NPROJ + C_GLR; const u32x4 l0 = *(const u32x4*)rp, l1 = *(const u32x4*)(rp + 8), l2 = *(const u32x4*)(rp + 16), l3 = *(const u32x4*)(rp + 24);
      gla_cum(p, l, 0, h, l0, l1, BcF, BEND);
      gla_cum(p, l, 1, h, l2, l3, BcB, BEND); }
    {
        const int j = tid >> 3, t = tc0 + j, dd = (tid & 7) * 4;
        const u32x2 qw = *(const u32x2*)(proj + (size_t)t * NPROJ + C_GQ + h * 32 + dd);
        const u32x2 kw = *(const u32x2*)(proj + (size_t)t * NPROJ + C_GK + h * 32 + dd);
        const float qf[4] = {bflo(qw.x), bfhi(qw.x), bflo(qw.y), bfhi(qw.y)}, kf[4] = {bflo(kw.x), bfhi(kw.x), bflo(kw.y), bfhi(kw.y)};
        const float qs = 0.17677669529663687f;
        float a0[4], a1[4], a2[4], a3[4];
#pragma unroll
        for (int e = 0; e < 4; ++e) { const float bf_ = BcF[j * 33 + dd + e], bb_ = BcB[j * 33 + dd + e];
            a0[e] = qf[e] * qs * __expf(bf_); a1[e] = qf[e] * qs * __expf(bb_); a2[e] = kf[e] * __expf(-bf_); a3[e] = kf[e] * __expf(-bb_); }
        u32x2 o; o.x = pk2(a0[0], a0[1]); o.y = pk2(a0[2], a0[3]); *(LAS u32x2*)(QD + j * 72 + dd) = o;
        o.x = pk2(a1[0], a1[1]); o.y = pk2(a1[2], a1[3]); *(LAS u32x2*)(QD + j * 72 + 32 + dd) = o;
        o.x = pk2(a2[0], a2[1]); o.y = pk2(a2[2], a2[3]); *(LAS u32x2*)(KD + j * 72 + dd) = o;
        o.x = pk2(a3[0], a3[1]); o.y = pk2(a3[2], a3[3]); *(LAS u32x2*)(KD + j * 72 + 32 + dd) = o;
        const int d0 = (tid & 7) * 8; float vv[8]; unpack8(*(const u32x4*)(proj + (size_t)t * NPROJ + C_GV + h * 64 + d0), vv);
#pragma unroll
        for (int e = 0; e < 8; ++e) VT[(d0 + e) * 72 + j] = f2bf(vv[e]);
        const int dir = tid >> 8, idx = (tid & 255) * 8, dv = idx >> 5, dk0 = idx & 31;
        *(LAS u32x4*)(ST + dv * 72 + dir * 32 + dk0) = *(const u32x4*)(glas + (size_t)gla_sidx(path, b, h, dir, c) * 2048 + idx);
    }
    __syncthreads();
    const int rb = w >> 1, cb0 = (w & 1) * 2;
#pragma unroll
    for (int i = 0; i < 2; ++i) {
        f32x4 af = {0.f, 0.f, 0.f, 0.f}, ab = af;
        af = mma_k<1>(QD, 72, rb * 16, 0, KD, 72, (cb0 + i) * 16, 0, af, lane);
        ab = mma_k<1>(QD, 72, rb * 16, 32, KD, 72, (cb0 + i) * 16, 32, ab, lane);
#pragma unroll
        for (int e = 0; e < 4; ++e) { const int ii = rb * 16 + q * 4 + e, jj = (cb0 + i) * 16 + r;
            float v = 0.f; if (jj <= ii) v += af[e]; if (jj >= ii) v += ab[e];
            P[ii * 72 + jj] = f2bf(v); }
    }
    __syncthreads();
#pragma unroll
    for (int i = 0; i < 2; ++i) {
        f32x4 a = {0.f, 0.f, 0.f, 0.f};
        a = mma_k<2>(P, 72, rb * 16, 0, VT, 72, (cb0 + i) * 16, 0, a, lane);
        a = mma_k<2>(QD, 72, rb * 16, 0, ST, 72, (cb0 + i) * 16, 0, a, lane);
#pragma unroll
        for (int e = 0; e < 4; ++e) O[(rb * 16 + q * 4 + e) * 65 + (cb0 + i) * 16 + r] = a[e];
    }
    __syncthreads();
    {
        const int i = tid >> 3, t = tc0 + i;
        headnorm_store(O, PIN(I_GGN) + l * 256 + h * 64, proj + (size_t)t * NPROJ + C_GG + h * 64, (bf16_t*)(p.ws + WS_BR) + (size_t)t * DM + 2 * 256 + h * 64, tid);
    }
    __syncthreads();
}

__device__ __forceinline__ size_t s5e_idx(int slot, int dir, int g, int seg) { return ((size_t)((slot * 2 + dir) * 16 + g) * 16 + seg) * 128; }
__device__ __forceinline__ void s5_item(const Ctx& p, int l, int path, int b, int dir, int gset, int seg0, LAS unsigned char* lds) {
    const int tid = get_tid(), lane = tid & 63, w = tid >> 6, r = lane & 15, q = lane >> 4;
    const int g = gset * 8 + w;
    LAS unsigned char* wl = lds + w * 16384;
    LAS bf16_t* U = (LAS bf16_t*)wl;
    LAS float* BU = (LAS float*)(wl + 1280);
    LAS bf16_t* XS = (LAS bf16_t*)(wl + 1280 + 8448);
    const bf16_t* proj = (const bf16_t*)(p.ws + WS_PROJ);
    float* s5y = (float*)(p.ws + WS_S5Y) + (size_t)dir * T_ALL * 256;
    const int tokb = (path ? T_CTX + b * 1024 : b * 256);
    const int ldg = (l * 2 + dir) * 16 + g;
    const float dt = __expf(PIN(I_S5DT)[ldg]);
    float ar, ai;
    { const float lre = PIN(I_S5LR)[ldg * 64 + lane], lim = PIN(I_S5LI)[ldg * 64 + lane]; const float m = __expf(lre * dt); float sn, cs; sincosf(lim * dt, &sn, &cs); ar = m * cs; ai = m * sn; }
    bf16x8 bfrag[8];
#pragma unroll
    for (int ct = 0; ct < 8; ++ct) {
        const int ps = (ct & 3) * 16 + r;
        const float lre = PIN(I_S5LR)[ldg * 64 + ps], lim = PIN(I_S5LI)[ldg * 64 + ps];
        const float m = __expf(lre * dt); float sn, cs; sincosf(lim * dt, &sn, &cs);
        const float nr = m * cs - 1.f, ni = m * sn, den = 1.f / (lre * lre + lim * lim);
        const float cr = (nr * lre + ni * lim) * den, cim = (ni * lre - nr * lim) * den;
        float vals[8];
        if (q < 2) {
            const float* br = PIN(I_S5BR) + ((size_t)ldg * 64 + ps) * 16 + q * 8; const float* bi = PIN(I_S5BI) + ((size_t)ldg * 64 + ps) * 16 + q * 8;
#pragma unroll
            for (int e = 0; e < 8; ++e) vals[e] = (ct < 4) ? (cr * br[e] - cim * bi[e]) : (cr * bi[e] + cim * br[e]);
        } else {
#pragma unroll
            for (int e = 0; e < 8; ++e) vals[e] = 0.f;
        }
        const u32x4 pk = pack8(vals); bfrag[ct] = *(const bf16x8*)&pk;
    }
    bf16x8 cfrag[4];
#pragma unroll
    for (int ks = 0; ks < 4; ++ks) {
        const int k0 = ks * 32 + q * 8; float vals[8];
        const float* src = (k0 < 64) ? PIN(I_S5CR) + ((size_t)ldg * 16 + r) * 64 + k0 : PIN(I_S5CI) + ((size_t)ldg * 16 + r) * 64 + (k0 - 64);
#pragma unroll
        for (int e = 0; e < 8; ++e) vals[e] = (k0 < 64) ? src[e] : -src[e];
        const u32x4 pk = pack8(vals); cfrag[ks] = *(const bf16x8*)&pk;
    }
    for (int i = lane; i < 16 * 40; i += 64) U[i] = 0;
    LDS_WAIT();
#pragma unroll 1
    for (int sg = 0; sg < 4; ++sg) {
    const int seg = seg0 + sg, tok0 = tokb + seg * 64;
    float xr = 0.f, xi = 0.f;
    const int ujj = (lane & 31) >> 1, uhalf = lane & 1;
    u32x4 unext;
    { const int pp = ujj, ti = dir ? 63 - pp : pp; unext = *(const u32x4*)(proj + (size_t)(tok0 + ti) * NPROJ + C_SU + g * 16 + uhalf * 8); }
#pragma unroll 1
    for (int sc = 0; sc < 4; ++sc) {
        if (lane < 32) *(LAS u32x4*)(U + ujj * 40 + uhalf * 8) = unext;
        if (sc + 1 < 4) { const int pp = (sc + 1) * 16 + ujj, ti = dir ? 63 - pp : pp; unext = *(const u32x4*)(proj + (size_t)(tok0 + ti) * NPROJ + C_SU + g * 16 + uhalf * 8); }
        LDS_WAIT();
        const bf16x8 afr = *(const LAS bf16x8*)(U + r * 40 + q * 8);
#pragma unroll
        for (int ct = 0; ct < 8; ++ct) { f32x4 a = {0.f, 0.f, 0.f, 0.f}; a = __builtin_amdgcn_mfma_f32_16x16x32_bf16(afr, bfrag[ct], a, 0, 0, 0);
#pragma unroll
            for (int e = 0; e < 4; ++e) BU[(q * 4 + e) * 132 + ct * 16 + r] = a[e]; }
        LDS_WAIT();
#pragma unroll
        for (int jj = 0; jj < 16; ++jj) { const float bur = BU[jj * 132 + lane], bui = BU[jj * 132 + 64 + lane];
            const float nr = ar * xr - ai * xi + bur, ni = ar * xi + ai * xr + bui; xr = nr; xi = ni;
            XS[jj * 136 + lane] = f2bf(xr); XS[jj * 136 + 64 + lane] = f2bf(xi); }
        LDS_WAIT();
        f32x4 y = {0.f, 0.f, 0.f, 0.f};
#pragma unroll
        for (int ks = 0; ks < 4; ++ks) { const bf16x8 xa = *(const LAS bf16x8*)(XS + r * 136 + ks * 32 + q * 8); y = __builtin_amdgcn_mfma_f32_16x16x32_bf16(xa, cfrag[ks], y, 0, 0, 0); }
#pragma unroll
        for (int e = 0; e < 4; ++e) { const int pp = sc * 16 + q * 4 + e, ti = dir ? 63 - pp : pp; s5y[(size_t)(tok0 + ti) * 256 + g * 16 + r] = y[e]; }
        LDS_WAIT();
    }
    { float* d = (float*)(p.ws + WS_S5E) + s5e_idx(path ? 16 + b : b, dir, g, seg) + lane * 2; d[0] = xr; d[1] = xi; }
    }

}

__device__ __forceinline__ void s5_glu_item(const Ctx& p, int l, int tile, LAS unsigned char* lds) {
    const int tid = get_tid(), lane = tid & 63, w = tid >> 6, r = lane & 15, q = lane >> 4;
    LAS bf16_t* GA = (LAS bf16_t*)lds;
    LAS bf16_t* Zw = GA + 64 * 264 + w * (16 * 136);
    const bf16_t* proj = (const bf16_t*)(p.ws + WS_PROJ);
    const float* yf = (const float*)(p.ws + WS_S5Y); const float* yb = yf + (size_t)T_ALL * 256;
    const float* s5e = (const float*)(p.ws + WS_S5E);
    const int t0 = tile * 64;
    const int path = tile >= 64 ? 1 : 0, tl = tile - 64;
    const int b = path ? tl >> 4 : tile >> 2, seg = path ? tl & 15 : tile & 3, nseg = path ? 16 : 4, slot = path ? 16 + b : b;
    f32x4 yc[2][4];
#pragma unroll
    for (int gi = 0; gi < 2; ++gi)
#pragma unroll
        for (int pc = 0; pc < 4; ++pc) yc[gi][pc] = (f32x4){0.f, 0.f, 0.f, 0.f};
#pragma unroll
    for (int gi = 0; gi < 2; ++gi) {
        const int g = 2 * w + gi;
#pragma unroll
        for (int dir = 0; dir < 2; ++dir) {
            const int ldg = (l * 2 + dir) * 16 + g;
            const float dt = __expf(PIN(I_S5DT)[ldg]);
            const float lre = PIN(I_S5LR)[ldg * 64 + lane], lim = PIN(I_S5LI)[ldg * 64 + lane];
            float ar, ai, ar64, ai64;
            { const float m = __expf(lre * dt); float sn, cs; sincosf(lim * dt, &sn, &cs); ar = m * cs; ai = m * sn; }
            { const float m = __expf(64.f * lre * dt); float sn, cs; sincosf(64.f * lim * dt, &sn, &cs); ar64 = m * cs; ai64 = m * sn; }
            float xr = 0.f, xi = 0.f;
            if (path) { const float* s0 = PIN(I_SS5) + ((size_t)(((b * 4 + l) * 2 + dir) * 16 + g) * 64 + lane) * 2; xr = s0[0]; xi = s0[1]; }
            const int nprev = dir ? nseg - 1 - seg : seg;
            { float er[15], ei[15];
#pragma unroll
              for (int k = 0; k < 15; ++k) { er[k] = 0.f; ei[k] = 0.f;
                  if (k < nprev) { const int sg = dir ? nseg - 1 - k : k; const float2 e = *(const float2*)(s5e + s5e_idx(slot, dir, g, sg) + lane * 2); er[k] = e.x; ei[k] = e.y; } }
#pragma unroll
              for (int k = 0; k < 15; ++k) if (k < nprev) { const float nr = ar64 * xr - ai64 * xi + er[k], ni = ar64 * xi + ai64 * xr + ei[k]; xr = nr; xi = ni; } }
            if (!path && seg == (dir ? 0 : nseg - 1)) {
                const float* e = s5e + s5e_idx(slot, dir, g, seg) + lane * 2;
                float* d = p.out + O_S5 + ((size_t)(((b * 4 + l) * 2 + dir) * 16 + g) * 64 + lane) * 2;
                d[0] = ar64 * xr - ai64 * xi + e[0]; d[1] = ar64 * xi + ai64 * xr + e[1]; }
            bf16x8 cfrag[4];
#pragma unroll
            for (int ks = 0; ks < 4; ++ks) {
                const int k0 = ks * 32 + q * 8; float vals[8];
                const float* src = (k0 < 64) ? PIN(I_S5CR) + ((size_t)ldg * 16 + r) * 64 + k0 : PIN(I_S5CI) + ((size_t)ldg * 16 + r) * 64 + (k0 - 64);
#pragma unroll
                for (int e = 0; e < 8; ++e) vals[e] = (k0 < 64) ? src[e] : -src[e];
                const u32x4 pk = pack8(vals); cfrag[ks] = *(const bf16x8*)&pk;
            }
            float zr = xr, zi = xi;
#pragma unroll
            for (int ppc = 0; ppc < 4; ++ppc) {
#pragma unroll 4
                for (int pj = 0; pj < 16; ++pj) { const float nr = ar * zr - ai * zi, ni = ar * zi + ai * zr; zr = nr; zi = ni;
                    const int row = dir ? 15 - pj : pj; Zw[row * 136 + lane] = f2bf(zr); Zw[row * 136 + 64 + lane] = f2bf(zi); }
                LDS_WAIT();
                f32x4 y = yc[gi][dir ? 3 - ppc : ppc];
#pragma unroll
                for (int ks = 0; ks < 4; ++ks) { const bf16x8 xa = *(const LAS bf16x8*)(Zw + r * 136 + ks * 32 + q * 8); y = __builtin_amdgcn_mfma_f32_16x16x32_bf16(xa, cfrag[ks], y, 0, 0, 0); }
                yc[gi][dir ? 3 - ppc : ppc] = y;
                LDS_WAIT();
            }
        }
    }
#pragma unroll
    for (int gi = 0; gi < 2; ++gi) {
        const int c = (2 * w + gi) * 16 + r; const float dsk = PIN(I_S5D)[l * 256 + c];
#pragma unroll
        for (int pc = 0; pc < 4; ++pc)
#pragma unroll
            for (int e = 0; e < 4; ++e) { const int i = pc * 16 + q * 4 + e, t = t0 + i;
                const float u = bf2f(proj[(size_t)t * NPROJ + C_SU + c]);
                const float y = yf[(size_t)t * 256 + c] + yb[(size_t)t * 256 + c] + yc[gi][pc][e] + dsk * u;
                const float inner = 0.7978845608028654f * (y + 0.044715f * y * y * y);
                GA[i * 264 + c] = f2bf(0.5f * y * (1.f + tanhf(inner))); }
    }
    __syncthreads();
    const bf16_t* wglu = (const bf16_t*)(p.ws + WS_W + (size_t)l * WL_STRIDE + WL_GLU);
    bf16_t* br = (bf16_t*)(p.ws + WS_BR);
#pragma unroll 1
    for (int ci = 0; ci < 2; ++ci) {
        const int cb = w + ci * 8;
        bf16x8 wa[8], wg[8];
#pragma unroll
        for (int ks = 0; ks < 8; ++ks) { wa[ks] = *(const bf16x8*)(wglu + (size_t)(cb * 16 + r) * 256 + ks * 32 + q * 8); wg[ks] = *(const bf16x8*)(wglu + (size_t)(256 + cb * 16 + r) * 256 + ks * 32 + q * 8); }
        const float ba = PIN(I_S5BG)[l * 512 + cb * 16 + r], bg = PIN(I_S5BG)[l * 512 + 256 + cb * 16 + r];
#pragma unroll 1
        for (int rb = 0; rb < 4; ++rb) {
            f32x4 aa = {0.f, 0.f, 0.f, 0.f}, ag = aa;
#pragma unroll
            for (int ks = 0; ks < 8; ++ks) { const bf16x8 af = *(const LAS bf16x8*)(GA + (rb * 16 + r) * 264 + ks * 32 + q * 8);
                aa = __builtin_amdgcn_mfma_f32_16x16x32_bf16(af, wa[ks], aa, 0, 0, 0); ag = __builtin_amdgcn_mfma_f32_16x16x32_bf16(af, wg[ks], ag, 0, 0, 0); }
#pragma unroll
            for (int e = 0; e < 4; ++e) { const int t = t0 + rb * 16 + q * 4 + e; br[(size_t)t * DM + 256 + cb * 16 + r] = f2bf((aa[e] + ba) * sigmoidf_(ag[e] + bg)); }
        }
    }
    __syncthreads();
}

__device__ __forceinline__ void na_item(const Ctx& p, int l, int kind, int b, int h, int qt, LAS unsigned char* lds) {
    const int tid = get_tid(), lane = tid & 63, w = tid >> 6, r = lane & 15, q = lane >> 4;
    LAS bf16_t* Qs = (LAS bf16_t*)lds; LAS bf16_t* Ks = Qs + 64 * 72; LAS bf16_t* VTs = Ks + 64 * 72; LAS bf16_t* Pb = VTs + 64 * 72;
    LAS float* Sb = (LAS float*)(Pb + 64 * 72); LAS float* ALPHA = Sb + 64 * 68; LAS float* LSUM = ALPHA + 64;
    const bf16_t* proj = (const bf16_t*)(p.ws + WS_PROJ);
    const int tq0 = kind ? T_CTX + b * 1024 + qt * 64 : b * 256 + qt * 64;
    const int nblk = kind ? 12 : 4;
    const int rs = kind ? min(max(qt - 4, 0), 8) : 0;
    const int j = tid >> 3, d0 = (tid & 7) * 8;
    *(LAS u32x4*)(Qs + j * 72 + d0) = *(const u32x4*)(proj + (size_t)(tq0 + j) * NPROJ + C_NQ + h * 64 + d0);
    const int rb = w >> 1, cb0 = (w & 1) * 2;
    f32x4 oacc[2] = {{0.f, 0.f, 0.f, 0.f}, {0.f, 0.f, 0.f, 0.f}};
    float mrun = -1e30f, lrun = 0.f;
    const float* rpb = PIN(I_RPB) + (size_t)(l * 4 + h) * 15 * 31;
    auto loadkv = [&](int blk, u32x4& kreg, u32x4& vreg) {
        if (kind == 0 || blk < 8) {
            const int tk = kind ? T_CTX + b * 1024 + (rs + blk) * 64 + j : b * 256 + blk * 64 + j;
            kreg = *(const u32x4*)(proj + (size_t)tk * NPROJ + C_NK + h * 64 + d0);
            vreg = *(const u32x4*)(proj + (size_t)tk * NPROJ + C_NV + h * 64 + d0);
        } else {
            const size_t off = ((size_t)((b * 4 + l) * 256 + (blk - 8) * 64 + j) * 4 + h) * 64 + d0;
            const f32x4 k0 = *(const f32x4*)(PIN(I_CK) + off), k1 = *(const f32x4*)(PIN(I_CK) + off + 4);
            const f32x4 v0 = *(const f32x4*)(PIN(I_CV) + off), v1 = *(const f32x4*)(PIN(I_CV) + off + 4);
            kreg.x = pk2(k0[0], k0[1]); kreg.y = pk2(k0[2], k0[3]); kreg.z = pk2(k1[0], k1[1]); kreg.w = pk2(k1[2], k1[3]);
            vreg.x = pk2(v0[0], v0[1]); vreg.y = pk2(v0[2], v0[3]); vreg.z = pk2(v1[0], v1[1]); vreg.w = pk2(v1[2], v1[3]);
        }
    };
    u32x4 knext, vnext;
    loadkv(0, knext, vnext);
    for (int blk = 0; blk < nblk; ++blk) {
        const u32x4 kreg = knext, vreg = vnext;
        *(LAS u32x4*)(Ks + j * 72 + d0) = kreg;
        if (blk + 1 < nblk) loadkv(blk + 1, knext, vnext);
        { const unsigned vw[4] = {vreg.x, vreg.y, vreg.z, vreg.w};
#pragma unroll
            for (int e = 0; e < 4; ++e) { VTs[(d0 + 2 * e) * 72 + j] = (bf16_t)(vw[e] & 0xffffu); VTs[(d0 + 2 * e + 1) * 72 + j] = (bf16_t)(vw[e] >> 16); } }
        __syncthreads();
        const bool local = kind && blk < 8;
#pragma unroll
        for (int i = 0; i < 2; ++i) {
            f32x4 a = {0.f, 0.f, 0.f, 0.f};
            a = mma_k<2>(Qs, 72, rb * 16, 0, Ks, 72, (cb0 + i) * 16, 0, a, lane);
#pragma unroll
            for (int e = 0; e < 4; ++e) { const int qi = rb * 16 + q * 4 + e, kc = (cb0 + i) * 16 + r;
                float sv = a[e] * 0.125f;
                if (local) { const int cs = min(max(qi - 8, 0), 48); const int ridx = rs + blk - qt + 7, cidx = min(max(kc - qi + 15, 0), 30);
                    sv = (kc >= cs && kc < cs + 16) ? sv + rpb[ridx * 31 + cidx] : -1e30f; }
                Sb[qi * 68 + kc] = sv; }
        }
        __syncthreads();
        {
            const int sub = tid & 7;
            const f32x4 s0 = *(const LAS f32x4*)(Sb + j * 68 + sub * 8), s1 = *(const LAS f32x4*)(Sb + j * 68 + sub * 8 + 4);
            float bm = fmaxf(fmaxf(fmaxf(s0[0], s0[1]), fmaxf(s0[2], s0[3])), fmaxf(fmaxf(s1[0], s1[1]), fmaxf(s1[2], s1[3])));
            bm = fmaxf(bm, __shfl_xor(bm, 1)); bm = fmaxf(bm, __shfl_xor(bm, 2)); bm = fmaxf(bm, __shfl_xor(bm, 4));
            const float mnew = fmaxf(mrun, bm), alpha = __expf(mrun - mnew);
            float pv[8];
#pragma unroll
            for (int e = 0; e < 4; ++e) { pv[e] = __expf(s0[e] - mnew); pv[4 + e] = __expf(s1[e] - mnew); }
            float ps = ((pv[0] + pv[1]) + (pv[2] + pv[3])) + ((pv[4] + pv[5]) + (pv[6] + pv[7]));
            ps += __shfl_xor(ps, 1); ps += __shfl_xor(ps, 2); ps += __shfl_xor(ps, 4);
            lrun = lrun * alpha + ps; mrun = mnew;
            *(LAS u32x4*)(Pb + j * 72 + sub * 8) = pack8(pv);
            if (sub == 0) ALPHA[j] = alpha;
        }
        __syncthreads();
#pragma unroll
        for (int i = 0; i < 2; ++i) {
#pragma unroll
            for (int e = 0; e < 4; ++e) oacc[i][e] *= ALPHA[rb * 16 + q * 4 + e];
            oacc[i] = mma_k<2>(Pb, 72, rb * 16, 0, VTs, 72, (cb0 + i) * 16, 0, oacc[i], lane);
        }
        __syncthreads();
    }
    if ((tid & 7) == 0) LSUM[j] = lrun;
    __syncthreads();
    bf16_t* br = (bf16_t*)(p.ws + WS_BR);
#pragma unroll
    for (int i = 0; i < 2; ++i)
#pragma unroll
        for (int e = 0; e < 4; ++e) { const int qi = rb * 16 + q * 4 + e; br[(size_t)(tq0 + qi) * DM + 768 + h * 64 + (cb0 + i) * 16 + r] = f2bf(oacc[i][e] / LSUM[qi]); }
    __syncthreads();
}

__device__ __forceinline__ void branch_phase(const Ctx& p, int l, LAS unsigned char* lds) {
    const int tid = get_tid(), lane = tid & 63, w = tid >> 6, r = lane & 15, q = lane >> 4;
    LAS bf16_t* As = (LAS bf16_t*)lds;
    const bf16_t* br = (const bf16_t*)(p.ws + WS_BR);
    const bf16_t* wb = (const bf16_t*)(p.ws + WS_W + (size_t)l * WL_STRIDE + WL_BR);
    const bf16_t* gates = (const bf16_t*)(p.ws + WS_GATES);
    bf16_t* merged = (bf16_t*)(p.ws + WS_MERGED);
    for (int tile = get_bid(); tile < 256; tile += get_nb()) {
        const int t0 = tile * 32;
#pragma unroll
        for (int i = 0; i < 8; ++i) { const int idx = i * 512 + tid, row = idx >> 7, c8 = (idx & 127) * 8;
            *(LAS u32x4*)(As + row * 1032 + c8) = *(const u32x4*)(br + (size_t)(t0 + row) * DM + c8); }
        __syncthreads();
#pragma unroll 1
        for (int ct = 0; ct < 8; ++ct) {
            const int d0 = w * 128 + ct * 16;
            f32x4 R[2] = {{0.f, 0.f, 0.f, 0.f}, {0.f, 0.f, 0.f, 0.f}};
            bf16x8 wf[8];
#pragma unroll
            for (int ks = 0; ks < 8; ++ks) wf[ks] = *(const bf16x8*)(wb + (size_t)(0 * 1024 + d0 + r) * 256 + ks * 32 + q * 8);
#pragma unroll
            for (int n = 0; n < 4; ++n) {
                bf16x8 wn[8];
                if (n < 3) {
#pragma unroll
                    for (int ks = 0; ks < 8; ++ks) wn[ks] = *(const bf16x8*)(wb + (size_t)((n + 1) * 1024 + d0 + r) * 256 + ks * 32 + q * 8);
                }
                u32x2 gw[2];
#pragma unroll
                for (int rt = 0; rt < 2; ++rt) gw[rt] = *(const u32x2*)(gates + (size_t)(t0 + rt * 16 + r) * NGATE + n * DM + d0 + q * 4);
                f32x4 U[2] = {{0.f, 0.f, 0.f, 0.f}, {0.f, 0.f, 0.f, 0.f}};
#pragma unroll
                for (int ks = 0; ks < 8; ++ks)
#pragma unroll
                    for (int rt = 0; rt < 2; ++rt) { const bf16x8 bfr = *(const LAS bf16x8*)(As + (rt * 16 + r) * 1032 + n * 256 + ks * 32 + q * 8);
                        U[rt] = __builtin_amdgcn_mfma_f32_16x16x32_bf16(wf[ks], bfr, U[rt], 0, 0, 0); }
#pragma unroll
                for (int rt = 0; rt < 2; ++rt) { R[rt][0] += bflo(gw[rt].x) * U[rt][0]; R[rt][1] += bfhi(gw[rt].x) * U[rt][1]; R[rt][2] += bflo(gw[rt].y) * U[rt][2]; R[rt][3] += bfhi(gw[rt].y) * U[rt][3]; }
                if (n < 3) {
#pragma unroll
                    for (int ks = 0; ks < 8; ++ks) wf[ks] = wn[ks];
                }
            }
#pragma unroll
            for (int rt = 0; rt < 2; ++rt) { u32x2 o; o.x = pk2(R[rt][0], R[rt][1]); o.y = pk2(R[rt][2], R[rt][3]);
                *(u32x2*)(merged + (size_t)(t0 + rt * 16 + r) * DM + d0 + q * 4) = o; }
        }
        __syncthreads();
    }
}

__device__ __forceinline__ void gate_sum_phase(const Ctx& p) {
    const int tid = get_tid();
    const bf16_t* gates = (const bf16_t*)(p.ws + WS_GATES);
    const bf16_t* up = (const bf16_t*)(p.ws + WS_PART);
    bf16_t* merged = (bf16_t*)(p.ws + WS_MERGED);
    const int NT = get_nb() * 512;
    for (int i = get_bid() * 512 + tid; i < T_ALL * 128; i += NT) {
        const int t = i >> 7, c8 = (i & 127) * 8;
        u32x4 g[4], u[4];
#pragma unroll
        for (int n = 0; n < 4; ++n) { g[n] = *(const u32x4*)(gates + (size_t)t * NGATE + n * DM + c8); u[n] = *(const u32x4*)(up + (size_t)t * NGATE + n * DM + c8); }
        float acc[8] = {0.f, 0.f, 0.f, 0.f, 0.f, 0.f, 0.f, 0.f};
#pragma unroll
        for (int n = 0; n < 4; ++n) { float gf[8], uf[8]; unpack8(g[n], gf); unpack8(u[n], uf);
#pragma unroll
            for (int e = 0; e < 8; ++e) acc[e] += gf[e] * uf[e]; }
        *(u32x4*)(merged + (size_t)t * DM + c8) = pack8(acc);
    }
}

__device__ __forceinline__ void na2_item(const Ctx& p, int l, int kind, int b, int h, int qt2, LAS unsigned char* lds) {
    const int tid = get_tid(), lane = tid & 63, w = tid >> 6, r = lane & 15, q = lane >> 4;
    LAS bf16_t* Qs = (LAS bf16_t*)lds;
    LAS bf16_t* Kb = Qs + 128 * 72;
    LAS bf16_t* Vb = Kb + 2 * 64 * 72;
    LAS bf16_t* Pw = Vb + 2 * 64 * 72 + w * (16 * 72);
    const bf16_t* proj = (const bf16_t*)(p.ws + WS_PROJ);
    const int tq0 = kind ? T_CTX + b * 1024 + qt2 * 128 : b * 256 + qt2 * 128;
    const int r0 = 2 * qt2;
    const int lo = kind ? min(max(r0 - 4, 0), 8) : 0, hi = kind ? min(max(r0 + 1 - 4, 0), 8) + 7 : 0;
    const int nloc = kind ? hi - lo + 1 : 0, nblk = nloc + 4;
    const int j = tid >> 3, d0 = (tid & 7) * 8;
#pragma unroll
    for (int i = 0; i < 2; ++i) { const int row = j + 64 * i; *(LAS u32x4*)(Qs + row * 72 + d0) = *(const u32x4*)(proj + (size_t)(tq0 + row) * NPROJ + C_NQ + h * 64 + d0); }
    auto loadkv = [&](int blk, u32x4& kreg, u32x4& vreg) {
        if (kind == 0 || blk < nloc) {
            const int tk = kind ? T_CTX + b * 1024 + (lo + blk) * 64 + j : b * 256 + blk * 64 + j;
            kreg = *(const u32x4*)(proj + (size_t)tk * NPROJ + C_NK + h * 64 + d0);
            vreg = *(const u32x4*)(proj + (size_t)tk * NPROJ + C_NV + h * 64 + d0);
        } else {
            const size_t off = ((size_t)((b * 4 + l) * 256 + (blk - nloc) * 64 + j) * 4 + h) * 64 + d0;
            const f32x4 k0 = *(const f32x4*)(PIN(I_CK) + off), k1 = *(const f32x4*)(PIN(I_CK) + off + 4);
            const f32x4 v0 = *(const f32x4*)(PIN(I_CV) + off), v1 = *(const f32x4*)(PIN(I_CV) + off + 4);
            kreg.x = pk2(k0[0], k0[1]); kreg.y = pk2(k0[2], k0[3]); kreg.z = pk2(k1[0], k1[1]); kreg.w = pk2(k1[2], k1[3]);
            vreg.x = pk2(v0[0], v0[1]); vreg.y = pk2(v0[2], v0[3]); vreg.z = pk2(v1[0], v1[1]); vreg.w = pk2(v1[2], v1[3]);
        }
    };
    u32x4 knext, vnext;
    loadkv(0, knext, vnext);
    f32x4 oacc[4];
#pragma unroll
    for (int dt = 0; dt < 4; ++dt) oacc[dt] = (f32x4){0.f, 0.f, 0.f, 0.f};
    float mrun[4] = {-1e30f, -1e30f, -1e30f, -1e30f}, lrun[4] = {0.f, 0.f, 0.f, 0.f};
    const float* rpb = PIN(I_RPB) + (size_t)(l * 4 + h) * 15 * 31;
    const int qrow = r0 + (w >> 2);
    const int rsq = min(max(qrow - 4, 0), 8);
    for (int blk = 0; blk < nblk; ++blk) {
        LAS bf16_t* Ks = Kb + (blk & 1) * (64 * 72); LAS bf16_t* VTs = Vb + (blk & 1) * (64 * 72);
        *(LAS u32x4*)(Ks + j * 72 + d0) = knext;
        { const unsigned vw[4] = {vnext.x, vnext.y, vnext.z, vnext.w};
#pragma unroll
            for (int e = 0; e < 4; ++e) { VTs[(d0 + 2 * e) * 72 + j] = (bf16_t)(vw[e] & 0xffffu); VTs[(d0 + 2 * e + 1) * 72 + j] = (bf16_t)(vw[e] >> 16); } }
        if (blk + 1 < nblk) loadkv(blk + 1, knext, vnext);
        __syncthreads();
        const bool local = kind && blk < nloc;
        const int kr = lo + blk;
        const bool rowok = !local || (kr >= rsq && kr < rsq + 8);
        f32x4 sc[4];
#pragma unroll
        for (int cb = 0; cb < 4; ++cb) { f32x4 a = {0.f, 0.f, 0.f, 0.f}; a = mma_k<2>(Qs, 72, w * 16, 0, Ks, 72, cb * 16, 0, a, lane);
#pragma unroll
            for (int e = 0; e < 4; ++e) { float sv = a[e] * 0.125f;
                if (local) { const int qc = (w & 3) * 16 + q * 4 + e, kc = cb * 16 + r, cs = min(max(qc - 8, 0), 48), cidx = min(max(kc - qc + 15, 0), 30);
                    sv = (rowok && kc >= cs && kc < cs + 16) ? sv + rpb[(kr - qrow + 7) * 31 + cidx] : -1e30f; }
                a[e] = sv; }
            sc[cb] = a; }
        float alpha[4];
#pragma unroll
        for (int e = 0; e < 4; ++e) {
            float bm = fmaxf(fmaxf(sc[0][e], sc[1][e]), fmaxf(sc[2][e], sc[3][e]));
            bm = fmaxf(bm, __shfl_xor(bm, 1)); bm = fmaxf(bm, __shfl_xor(bm, 2)); bm = fmaxf(bm, __shfl_xor(bm, 4)); bm = fmaxf(bm, __shfl_xor(bm, 8));
            const float mnew = fmaxf(mrun[e], bm); alpha[e] = __expf(mrun[e] - mnew); mrun[e] = mnew;
            float ps = 0.f;
#pragma unroll
            for (int cb = 0; cb < 4; ++cb) { const float sv = sc[cb][e]; const float pv = (sv > -1e29f) ? __expf(sv - mnew) : 0.f; sc[cb][e] = pv; ps += pv; }
            ps += __shfl_xor(ps, 1); ps += __shfl_xor(ps, 2); ps += __shfl_xor(ps, 4); ps += __shfl_xor(ps, 8);
            lrun[e] = lrun[e] * alpha[e] + ps;
        }
#pragma unroll
        for (int cb = 0; cb < 4; ++cb)
#pragma unroll
            for (int e = 0; e < 4; ++e) Pw[(q * 4 + e) * 72 + cb * 16 + r] = f2bf(sc[cb][e]);
#pragma unroll
        for (int dt = 0; dt < 4; ++dt)
#pragma unroll
            for (int e = 0; e < 4; ++e) oacc[dt][e] *= alpha[e];
        LDS_WAIT();
#pragma unroll
        for (int dt = 0; dt < 4; ++dt) oacc[dt] = mma_k<2>(Pw, 72, 0, 0, VTs, 72, dt * 16, 0, oacc[dt], lane);
        LDS_WAIT();
    }
    bf16_t* br = (bf16_t*)(p.ws + WS_BR);
#pragma unroll
    for (int dt = 0; dt < 4; ++dt)
#pragma unroll
        for (int e = 0; e < 4; ++e) br[(size_t)(tq0 + w * 16 + q * 4 + e) * DM + 768 + h * 64 + dt * 16 + r] = f2bf(oacc[dt][e] / lrun[e]);
    __syncthreads();
}

__device__ __forceinline__ void mixer_phase1(const Ctx& p, int l, LAS unsigned char* lds, int qoff) {
    const int tid = get_tid();
    volatile LAS int* slot = (volatile LAS int*)(lds + LDS_MAIN + 32);
    unsigned* ctr = (unsigned*)(p.ws + WS_CTR) + l * 64 + qoff;
    for (;;) {
        if (tid == 0) *slot = (int)atomicAdd(ctr, 1u);
        __syncthreads();
        const int it = *slot;
        __syncthreads();
        if (it >= 704) break;
        if (it < 32) { const int r = it; gla_state_item(p, l, 1, r >> 3, (r >> 1) & 3, r & 1, lds); }
        else if (it < 64) { const int r = it - 32; ret_state_item(p, l, 1, r >> 3, (r >> 1) & 3, r & 1, lds); }
        else if (it < 192) { const int r = it - 64; na2_item(p, l, 1, r >> 5, (r >> 3) & 3, r & 7, lds); }
        else if (it < 320) { const int r = it - 192;
            if (r < 64) { const int rr = r; s5_item(p, l, 1, rr >> 4, (rr >> 3) & 1, (rr >> 2) & 1, (rr & 3) * 4, lds); }
            else { const int rr = r - 64; s5_item(p, l, 0, rr >> 2, (rr >> 1) & 1, rr & 1, 0, lds); }
            __syncthreads(); }
        else if (it < 448) { const int r = it - 320; gla_state_item(p, l, 0, r >> 3, (r >> 1) & 3, r & 1, lds); }
        else if (it < 576) { const int r = it - 448; na2_item(p, l, 0, r >> 3, (r >> 1) & 3, r & 1, lds); }
        else { const int r = it - 576; ret_state_item(p, l, 0, r >> 3, (r >> 1) & 3, r & 1, lds); }
    }
}
__device__ __forceinline__ void mixer_phase2(const Ctx& p, int l, LAS unsigned char* lds, int qoff) {
    const int tid = get_tid();
    volatile LAS int* slot = (volatile LAS int*)(lds + LDS_MAIN + 32);
    unsigned* ctr = (unsigned*)(p.ws + WS_CTR) + l * 64 + 32 + qoff;
    for (;;) {
        if (tid == 0) *slot = (int)atomicAdd(ctr, 1u);
        __syncthreads();
        const int it = *slot;
        __syncthreads();
        if (it >= 1152) break;
        if (it < 128) s5_glu_item(p, l, 127 - it, lds);
        else {
            const int r = (it - 128) & 511; const bool gla = it >= 640;
            int path, b, h, c;
            if (r < 256) { path = 1; b = r >> 6; h = (r >> 4) & 3; c = r & 15; } else { const int rr = r - 256; path = 0; b = rr >> 4; h = (rr >> 2) & 3; c = rr & 3; }
            if (gla) gla_out_item(p, l, path, b, h, c, lds); else ret_out_item(p, l, path, b, h, c, lds);
        }
    }
}

__global__ void __launch_bounds__(512) fwd_megakernel(Params p) {
    extern __shared__ __attribute__((aligned(16))) unsigned char smem_raw[];
    LAS unsigned char* lds = (LAS unsigned char*)smem_raw;
    cg::grid_group grid = cg::this_grid();
    const int G = get_nb(), c = get_bid();
    const int ph_lo = p.ph_lo, ph_hi = p.ph_hi;
    volatile LAS unsigned* bst = (volatile LAS unsigned*)(lds + LDS_MAIN);
    if (threadIdx.x < 16) bst[threadIdx.x] = 0u;
    __syncthreads();
    if (threadIdx.x == 0) (void)xb_add(&((unsigned*)(p.ws + WS_BAR))[XB_XCNT(xb_xcc_id())], 1u);
    if (ph_hi > 1000) grid.sync();
#define GRID_SYNC() xcd_barrier((unsigned*)(p.ws + WS_BAR), bst)
#ifndef NO_P0
    if (ph_lo == 0) phase0(p, lds);
#if defined(PROBE_DUP) && PROBE_DUP == 100
    GRID_SYNC(); if (ph_lo == 0) phase0(p, lds);
#endif
#endif
    for (int ph = (ph_lo == 0 ? 1 : ph_lo); ph < ph_hi; ++ph) {
        if (ph > ph_lo) GRID_SYNC();
        Ctx q;
        { GAS unsigned char* ws = (GAS unsigned char*)p.ws; GAS float* out = (GAS float*)p.out; asm volatile("" : "+s"(ws), "+s"(out)); q.ws = (unsigned char*)ws; q.out = (float*)out; q.in = (const GAS float* const*)(q.ws + WS_TAB); }
        if (ph == 41) { row_phase(q, 4, 0); continue; }
        const int l = (ph - 1) / 10, k = (ph - 1) % 10;
#if !(defined(PROBE_DUP) && PROBE_DUP < 100)
#define QOFF 0
#endif
#if defined(PROBE_DUP) && PROBE_DUP < 100
#define QOFF (rep * 8)
        for (int rep = 0; rep < ((k == PROBE_DUP) ? 2 : 1); ++rep) {
        if (rep) GRID_SYNC();
#endif
#if defined(PROBE_DUP) && PROBE_DUP == 101
        GRID_SYNC();
#endif
        unsigned char* wl = q.ws + WS_W + (size_t)l * WL_STRIDE;
        if (k == 0) { row_phase(q, l, 0); continue; }
#ifndef NO_M1
        if (k == 2) { mixer_phase1(q, l, lds, QOFF); continue; }
#endif
#ifndef NO_M2
        if (k == 3) { mixer_phase2(q, l, lds, QOFF); continue; }
#endif
        if (k == 7) { row_phase(q, l, 1); continue; }
        if (k == 5) { gate_sum_phase(q); continue; }
#ifndef NO_GEMM
        pg8::Sched S; pg8::Gemm g; pg8::Epi E;
        E.l = l; E.bias = ((const float*)q.in[I_BMG]) + (size_t)l * 4096; E.nak = q.out + O_NAK; E.nav = q.out + O_NAV;
        E.g16 = (bf16_t*)(q.ws + WS_GATES); E.f32 = (float*)(q.ws + WS_PART);
        if (k == 1) { S.init(32, 28, G, c, 0, 0u); g = pg8::Gemm{(const bf16_t*)(q.ws + WS_H), (const bf16_t*)(wl + WL_CAT), 1024, 1024, 1024}; E.mode = 0; E.o16 = (bf16_t*)(q.ws + WS_PROJ); }
        else if (k == 4) { S.init(32, 16, G, c, 3, 0u); g = pg8::Gemm{(const bf16_t*)(q.ws + WS_BR), (const bf16_t*)(wl + WL_BR), 256, 1024, 256}; E.mode = 4; E.o16 = (bf16_t*)(q.ws + WS_PART); }
        else if (k == 6) { S.init(32, 8, G, c, 1, 512u * 2u); g = pg8::Gemm{(const bf16_t*)(q.ws + WS_MERGED), (const bf16_t*)(wl + WL_OUT), 512, 1024, 1024}; E.mode = 2; E.o16 = nullptr; }
        else if (k == 8) { S.init(32, 16, G, c, 0, 0u); g = pg8::Gemm{(const bf16_t*)(q.ws + WS_H), (const bf16_t*)(wl + WL_M1), 1024, 1024, 1024}; E.mode = 3; E.o16 = (bf16_t*)(q.ws + WS_GATES); }
        else { S.init(32, 8, G, c, 1, 2048u * 2u); g = pg8::Gemm{(const bf16_t*)(q.ws + WS_GATES), (const bf16_t*)(wl + WL_M2), 2048, 4096, 4096}; E.mode = 2; E.o16 = nullptr; }
        pg8::gemm_phase(lds, g, S, E);
#endif
#if defined(PROBE_DUP) && PROBE_DUP < 100
        }
#endif
    }
}

extern "C" void kernel_launch(void* const* d_in, const int* in_sizes, int n_in, void* d_out, int out_size, void* d_ws, size_t ws_size, hipStream_t stream) {
    static int grid_blocks = 0;
    if (grid_blocks == 0) {
        if (n_in != N_IN || ws_size < WS_END) { fprintf(stderr, "kernel_launch: unexpected inputs (n_in %d, ws %zu, need %zu)\n", n_in, ws_size, (size_t)WS_END); grid_blocks = -1; return; }
        int dev = 0, cus = 0, per_cu = 0;
        hipGetDevice(&dev);
        hipDeviceGetAttribute(&cus, hipDeviceAttributeMultiprocessorCount, dev);
        if (hipFuncSetAttribute((const void*)fwd_megakernel, hipFuncAttributeMaxDynamicSharedMemorySize, LDS_BYTES) != hipSuccess) { fprintf(stderr, "kernel_launch: hipFuncSetAttribute failed\n"); (void)hipGetLastError(); }
        if (hipOccupancyMaxActiveBlocksPerMultiprocessor(&per_cu, (const void*)fwd_megakernel, 512, LDS_BYTES) != hipSuccess || per_cu < 1) { fprintf(stderr, "kernel_launch: occupancy query gave %d\n", per_cu); (void)hipGetLastError(); per_cu = 1; }
        grid_blocks = cus;
    }
    if (grid_blocks < 0) return;
    if (hipMemsetAsync((unsigned char*)d_ws + WS_BAR, 0, 16384 + 4096, stream) != hipSuccess) { fprintf(stderr, "kernel_launch: memset failed\n"); return; }
    Params p{};
    for (int i = 0; i < N_IN; ++i) p.in[i] = (const float*)d_in[i];
    p.out = (float*)d_out; p.ws = (unsigned char*)d_ws; p.ph_lo = 0; p.ph_hi = 42;
    void* args[] = {&p};
    hipError_t e = hipLaunchCooperativeKernel((const void*)fwd_megakernel, dim3(grid_blocks), dim3(512), args, LDS_BYTES, stream);
    if (e != hipSuccess) fprintf(stderr, "cooperative launch failed: %s (grid %d)\n", hipGetErrorString(e), grid_blocks);
}
```

```cpp
#include <hip/hip_runtime.h>
#include <hip/hip_cooperative_groups.h>
#include <cstdio>
#include <cstdint>
namespace cg = cooperative_groups;

#define LAS __attribute__((address_space(3)))
#define GAS __attribute__((address_space(1)))
typedef unsigned short bf16_t;
typedef short bf16x8 __attribute__((ext_vector_type(8)));
typedef float f32x4 __attribute__((ext_vector_type(4)));
typedef unsigned u32x4 __attribute__((ext_vector_type(4)));
typedef unsigned u32x2 __attribute__((ext_vector_type(2)));

constexpr int T_ALL = 8192, T_CTX = 4096, DM = 1024, NPROJ = 3072, NGATE = 4096, DFF = 4096;
constexpr int C_RQ = 0, C_RK = 256, C_RV = 512, C_RG = 768, C_SU = 1024, C_GQ = 1280, C_GK = 1408, C_GV = 1536, C_GG = 1792,
              C_NQ = 2048, C_NK = 2304, C_NV = 2560, C_GLR = 2816;
constexpr float EPS = 1e-6f;
enum { I_XP = 0, I_XS, I_C, I_CK, I_CV, I_SRET, I_SS5, I_SGLA, I_CCTX, I_WADA, I_BADA, I_GN, I_WIN, I_RLD, I_RGN, I_S5LR, I_S5LI, I_S5DT,
       I_S5BR, I_S5BI, I_S5CR, I_S5CI, I_S5D, I_S5WG, I_S5BG, I_GWG, I_GBG, I_GGN, I_RPB, I_WBR, I_WMG, I_BMG, I_WOUT, I_W1, I_W2, N_IN };
constexpr size_t O_X = 0, O_NAK = 8388608, O_NAV = 12582912, O_RET = 16777216, O_S5 = 18874368, O_GLA = 19136512;
constexpr size_t WL_CAT = 0, WL_BR = 14680064, WL_OUT = WL_BR + 2097152, WL_M1 = WL_OUT + 2097152, WL_M2 = WL_M1 + 8388608, WL_GLU = WL_M2 + 8388608,
                 WL_STRIDE = WL_GLU + 262144;
constexpr size_t WS_W = 0, WS_MOD = WS_W + 4 * WL_STRIDE, WS_H = WS_MOD + 491520, WS_PROJ = WS_H + 16777216, WS_GATES = WS_PROJ + 50331648,
                 WS_BR = WS_GATES + 67108864, WS_MERGED = WS_BR + 16777216, WS_PART = WS_MERGED + 16777216, WS_TAB = WS_PART + 67108864, WS_BAR = WS_TAB + 4096, WS_CTR = WS_BAR + 16384, WS_END = WS_CTR + 4096;
constexpr size_t WS_S5Y = WS_PART, WS_RETS = WS_PART + 16777216, WS_GLAS = WS_RETS + 8388608, WS_S5E = WS_GLAS + 4194304;
constexpr int LDS_MAIN = 131072, LDS_BYTES = LDS_MAIN + 64;

struct Params { const float* in[N_IN]; float* out; unsigned char* ws; int ph_lo, ph_hi; };
struct Ctx { const GAS float* const* in; float* out; unsigned char* ws; };
#define PIN(i) ((const float*)(p.in[i]))

typedef float f32x2_t __attribute__((ext_vector_type(2)));
typedef __bf16 bf16x2_t __attribute__((ext_vector_type(2)));
__device__ __forceinline__ unsigned pk2(float lo, float hi) { const f32x2_t v = {lo, hi}; const bf16x2_t h = __builtin_convertvector(v, bf16x2_t); return __builtin_bit_cast(unsigned, h); }
__device__ __forceinline__ bf16_t f2bf(float f) { return (bf16_t)(pk2(f, 0.f) & 0xffffu); }
__device__ __forceinline__ float bflo(unsigned u) { return __uint_as_float(u << 16); }
__device__ __forceinline__ float bfhi(unsigned u) { return __uint_as_float(u & 0xffff0000u); }
__device__ __forceinline__ float bf2f(bf16_t b) { return __uint_as_float(((unsigned)b) << 16); }
__device__ __forceinline__ void unpack8(u32x4 v, float (&f)[8]) { f[0] = bflo(v.x); f[1] = bfhi(v.x); f[2] = bflo(v.y); f[3] = bfhi(v.y); f[4] = bflo(v.z); f[5] = bfhi(v.z); f[6] = bflo(v.w); f[7] = bfhi(v.w); }
__device__ __forceinline__ u32x4 pack8(const float (&f)[8]) { u32x4 o; o.x = pk2(f[0], f[1]); o.y = pk2(f[2], f[3]); o.z = pk2(f[4], f[5]); o.w = pk2(f[6], f[7]); return o; }
__device__ __forceinline__ float sigmoidf_(float x) { return __builtin_amdgcn_rcpf(1.f + __expf(-x)); }
__device__ __forceinline__ float siluf_(float x) { return x * sigmoidf_(x); }
__device__ __forceinline__ float wave_sum(float v) {
#pragma unroll
    for (int o = 1; o < 64; o <<= 1) v += __shfl_xor(v, o);
    return v;
}
__device__ __forceinline__ int get_tid() { int t = threadIdx.x; asm volatile("" : "+v"(t)); return t; }
__device__ __forceinline__ int get_bid() { int b = blockIdx.x; asm volatile("" : "+s"(b)); return b; }
__device__ __forceinline__ int get_nb() { int b = gridDim.x; asm volatile("" : "+s"(b)); return b; }
#define LDS_WAIT() asm volatile("s_waitcnt lgkmcnt(0)" ::: "memory")

template <int KSTEPS>
__device__ __forceinline__ f32x4 mma_k(const LAS bf16_t* A, int lda, int arow0, int ak0, const LAS bf16_t* B, int ldb, int brow0, int bk0, f32x4 acc, int lane) {
    const int r = lane & 15, q = lane >> 4;
    const LAS bf16_t* ap = A + (arow0 + r) * lda + ak0 + q * 8;
    const LAS bf16_t* bp = B + (brow0 + r) * ldb + bk0 + q * 8;
#pragma unroll
    for (int kk = 0; kk < KSTEPS; ++kk) {
        const bf16x8 a = *(const LAS bf16x8*)(ap + kk * 32), b = *(const LAS bf16x8*)(bp + kk * 32);
        acc = __builtin_amdgcn_mfma_f32_16x16x32_bf16(a, b, acc, 0, 0, 0);
    }
    return acc;
}


#define XB_TMO      128
#define XB_XCNT(j)  (256  + 64 * (j))
#define XB_XSUB(j)  (1280 + 64 * (j))
#define XB_XGEN(j)  (2304 + 64 * (j))
#define XB_TOP      3328
#define XB_TOPGEN   3392
#define XCD_BAR_WORDS 3456
#define XB_SPIN_CAP (1u << 20)
__device__ __forceinline__ unsigned xb_ld(unsigned* p)              { return __hip_atomic_load(p, __ATOMIC_RELAXED, __HIP_MEMORY_SCOPE_AGENT); }
__device__ __forceinline__ unsigned xb_add(unsigned* p, unsigned v) { return __hip_atomic_fetch_add(p, v, __ATOMIC_RELAXED, __HIP_MEMORY_SCOPE_AGENT); }
__device__ __forceinline__ unsigned xb_xcc_id() { return (unsigned)__builtin_amdgcn_s_getreg((3 << 11) | 20) & 0xFu; }
#define XB_SPIN(cond, bar) do { unsigned _sp = 0; while (cond) { __builtin_amdgcn_s_sleep(1); \
    if ((++_sp & 255u) == 0u) { if (xb_ld(&(bar)[XB_TMO])) break; if (_sp > XB_SPIN_CAP) { atomicAdd(&(bar)[XB_TMO], 1u); break; } } } } while (0)
__device__ __forceinline__ void xcd_barrier_complete(unsigned* bar, unsigned x, unsigned& nloc, unsigned& nx) {
    const unsigned G = gridDim.x;
    unsigned sum, cnt, mine, sp = 0u;
    for (;;) {
        sum = 0u; cnt = 0u; mine = 0u;
#pragma unroll
        for (unsigned j = 0; j < 16; ++j) { const unsigned c = xb_ld(&bar[XB_XCNT(j)]); sum += c; cnt += (c > 0u) ? 1u : 0u; mine = (j == x) ? c : mine; }
        if (sum == G) break;
        __builtin_amdgcn_s_sleep(1);
        if ((++sp & 255u) == 0u) { if (xb_ld(&bar[XB_TMO])) break; if (sp > XB_SPIN_CAP) { atomicAdd(&bar[XB_TMO], 1u); break; } }
    }
    nloc = mine > 0u ? mine : 1u; nx = cnt > 0u ? cnt : 1u;
}
__device__ __forceinline__ void xcd_barrier(unsigned* bar, volatile LAS unsigned* st) {
    asm volatile("s_waitcnt vmcnt(0)" ::: "memory");
    __syncthreads();
    if (threadIdx.x == 0) {
        __builtin_amdgcn_s_waitcnt(0);
        const unsigned x = xb_xcc_id();
        unsigned nloc = st[0], nx = st[1];
        if (nloc == 0u) { xcd_barrier_complete(bar, x, nloc, nx); st[0] = nloc; st[1] = nx; }
        const unsigned old = xb_add(&bar[XB_XSUB(x)], 1u);
        const unsigned gen = old / nloc;
        if (old + 1u == (gen + 1u) * nloc) {
            __builtin_amdgcn_fence(__ATOMIC_RELEASE, "agent");
            asm volatile("s_waitcnt vmcnt(0)" ::: "memory");
            const unsigned og = xb_add(&bar[XB_TOP], 1u);
            const unsigned tg = og / nx;
            if (og + 1u == (tg + 1u) * nx) xb_add(&bar[XB_TOPGEN], 1u);
            else XB_SPIN(xb_ld(&bar[XB_TOPGEN]) == tg, bar);
            __builtin_amdgcn_fence(__ATOMIC_ACQUIRE, "agent");
            xb_add(&bar[XB_XGEN(x)], 1u);
            asm volatile("s_waitcnt vmcnt(0)" ::: "memory");
        } else {
            XB_SPIN(xb_ld(&bar[XB_XGEN(x)]) == gen, bar);
            __builtin_amdgcn_fence(__ATOMIC_ACQUIRE, "agent");
            asm volatile("s_waitcnt vmcnt(0)" ::: "memory");
        }
    }
    __syncthreads();
}

namespace pg8 {
constexpr int BM = 256, BK = 64, HALF = 128, HTB = HALF * BK * 2, NXCD = 8, WGM = 8;
__device__ __forceinline__ int lds_byte(int r, int c) { const int st = (r >> 4) * 2 + (c >> 5), rr = r & 15, cc = c & 31, ob = rr * 64 + cc * 2; return st * 1024 + (ob ^ (((ob >> 9) & 1) << 5)); }
__device__ __forceinline__ void stage_rc(int b, int& R, int& C) { const int st = b / 1024, sb = b % 1024, swz = sb ^ (((sb >> 9) & 1) << 5); R = (st >> 1) * 16 + swz / 64; C = (st & 1) * 32 + (swz % 64) / 2; }
__device__ __forceinline__ int perm32(int rho) { const int n = rho >> 4, i = rho & 15; return 8 * (i >> 2) + 4 * n + (i & 3); }
struct Unit { int pm, pn, tag; };
struct Gemm { const bf16_t* A; const bf16_t* Bt; int K, lda, ldb; };
struct Sched {
    int nM, nN, nwg, G, c, mode; unsigned amul, bmul;
    __device__ __forceinline__ void init(int nM_, int nN_, int G_, int c_, int mode_, unsigned koff_) { nM = nM_; nN = nN_; nwg = nM * nN; G = G_; c = c_; mode = mode_; amul = (mode_ == 2 || mode_ == 3) ? 512u : koff_; bmul = (mode_ == 2) ? 524288u : (mode_ == 3 ? 0u : koff_); }
    __device__ __forceinline__ bool next(int i, Unit& u) const {
        if (mode == 2) {
            if (c >= 128 || i >= 4) return false;
            u.pm = c >> 2; u.pn = c & 3; u.tag = i; return true;
        }
        const long L = (long)i * G + c; if (L >= nwg) return false;
        int wgid = (int)L; { const int q = nwg / NXCD, r = nwg % NXCD, xcd = wgid % NXCD, off = wgid / NXCD; wgid = (xcd < r ? xcd * (q + 1) : r * (q + 1) + (xcd - r) * q) + off; }
        const int nig = WGM * nN, gid = wgid / nig, fm = gid * WGM, gsz = (nM - fm) < WGM ? (nM - fm) : WGM;
        u.pm = fm + ((wgid % nig) % gsz); const int pnx = (wgid % nig) / gsz;
        if (mode == 1) { u.pn = pnx & 3; u.tag = pnx >> 2; }
        else if (mode == 3) { u.pn = pnx; u.tag = pnx >> 2; }
        else { u.pn = pnx; u.tag = 0; }
        return true;
    }
};

template <class Epi>
__device__ __forceinline__ void gemm_phase(LAS unsigned char* lds, const Gemm g, const Sched& S, const Epi& E) {
    const int tid = get_tid(), wid = __builtin_amdgcn_readfirstlane(tid >> 6), lane = tid & 63, wr = wid >> 2, wc = wid & 3, fr = lane & 15, fq = lane >> 4;
    const int K = g.K, nt = K / BK;
    unsigned voffA[2], voffB[2];
#pragma unroll
    for (int i = 0; i < 2; ++i) { int R, C; stage_rc(tid * 16 + i * 8192, R, C); const int Rb = Epi::PERM ? ((R & ~31) + perm32(R & 31)) : R;
        voffA[i] = (unsigned)(R * g.lda + C) * 2u; voffB[i] = (unsigned)(Rb * g.ldb + C) * 2u; }
    const size_t kstep = (size_t)(BK * 2);
    const size_t hstepA = (size_t)HALF * g.lda * 2, hstepB = (size_t)HALF * g.ldb * 2;
    const size_t tstepA = 2 * hstepA, tstepB = 2 * hstepB;
    const unsigned ldsw = (unsigned)wid * 1024u;
    const int aoff = lds_byte(wr * 64 + fr, fq * 8), boff = lds_byte(wc * 32 + fr, fq * 8);
#define PG8_SA(b, h) (((b) * 2 + (h)) * HTB)
#define PG8_SB(b, h) ((4 + (b) * 2 + (h)) * HTB)
#define PG8_STAGE(bufoff, gbase, voff) do { _Pragma("unroll") for (int _i = 0; _i < 2; ++_i) \
        __builtin_amdgcn_global_load_lds((const unsigned*)((const char*)(gbase) + (voff)[_i]), (LAS unsigned*)(lds + (bufoff) + ldsw + _i * 8192), 16, 0, 0); } while (0)
#define PG8_LDA(dst, b, h) do { _Pragma("unroll") for (int m = 0; m < 4; ++m) _Pragma("unroll") for (int k = 0; k < 2; ++k) dst[m][k] = *(const LAS bf16x8*)(lds + PG8_SA(b, h) + aoff + m * 2048 + k * 1024); } while (0)
#define PG8_LDB(dst, b, h) do { _Pragma("unroll") for (int n = 0; n < 2; ++n) _Pragma("unroll") for (int k = 0; k < 2; ++k) dst[n][k] = *(const LAS bf16x8*)(lds + PG8_SB(b, h) + boff + n * 2048 + k * 1024); } while (0)
#define PG8_MMA(ai, bj, At, Bt) do { __builtin_amdgcn_s_setprio(1); _Pragma("unroll") for (int m = 0; m < 4; ++m) _Pragma("unroll") for (int n = 0; n < 2; ++n) _Pragma("unroll") for (int k = 0; k < 2; ++k) \
        acc[ai][bj][m][n] = __builtin_amdgcn_mfma_f32_16x16x32_bf16(Bt[n][k], At[m][k], acc[ai][bj][m][n], 0, 0, 0); __builtin_amdgcn_s_setprio(0); } while (0)
#define PG8_WAIT_V(n) asm volatile("s_waitcnt vmcnt(" #n ")" ::: "memory")
#define PG8_WAIT_L(n) asm volatile("s_waitcnt lgkmcnt(" #n ")" ::: "memory")
#define PG8_BAR __builtin_amdgcn_s_barrier()
#define PG8_SCHED __builtin_amdgcn_sched_barrier(0)
    Unit cur, nxt; int ui = 0;
    if (!S.next(0, cur)) return;
    f32x4 acc[2][2][4][2];
#pragma unroll
    for (int a = 0; a < 2; ++a)
#pragma unroll
        for (int b = 0; b < 2; ++b)
#pragma unroll
            for (int m = 0; m < 4; ++m)
#pragma unroll
                for (int n = 0; n < 2; ++n) acc[a][b][m][n] = (f32x4){0.f, 0.f, 0.f, 0.f};
    bf16x8 At[4][2], B0[2][2], B1[2][2];
    const char* cA = (const char*)g.A + (size_t)cur.pm * tstepA + (size_t)cur.tag * S.amul; const char* cB = (const char*)g.Bt + (size_t)cur.pn * tstepB + (size_t)cur.tag * S.bmul;
    PG8_STAGE(PG8_SB(0, 0), cB, voffB); PG8_STAGE(PG8_SB(0, 1), cB + hstepB, voffB); PG8_STAGE(PG8_SA(0, 0), cA, voffA); PG8_STAGE(PG8_SA(0, 1), cA + hstepA, voffA);
    if (wr == 1) PG8_BAR;
    PG8_WAIT_V(2); PG8_BAR;
    PG8_STAGE(PG8_SB(1, 0), cB + kstep, voffB); PG8_STAGE(PG8_SA(1, 0), cA + kstep, voffA); PG8_STAGE(PG8_SB(1, 1), cB + hstepB + kstep, voffB);
    PG8_WAIT_V(6); PG8_BAR;
    for (;;) {
        const bool has_next = S.next(ui + 1, nxt);
        const char* nA = has_next ? (const char*)g.A + (size_t)nxt.pm * tstepA + (size_t)nxt.tag * S.amul : cA; const char* nB = has_next ? (const char*)g.Bt + (size_t)nxt.pn * tstepB + (size_t)nxt.tag * S.bmul : cB;
        for (int t = 0; t < nt; t += 2) {
            const bool last = (t == nt - 2);
            const char* a1 = cA + (size_t)(t + 1) * kstep;
            const char* a2 = last ? nA : cA + (size_t)(t + 2) * kstep; const char* b2 = last ? nB : cB + (size_t)(t + 2) * kstep;
            const char* a3 = a2 + kstep; const char* b3 = b2 + kstep;
            PG8_LDB(B0, 0, 0); PG8_LDB(B1, 0, 1); PG8_SCHED; PG8_LDA(At, 0, 0); PG8_STAGE(PG8_SA(1, 1), a1 + hstepA, voffA);
            PG8_WAIT_V(8); PG8_WAIT_L(0); PG8_BAR; PG8_MMA(0, 0, At, B0); PG8_MMA(0, 1, At, B1); PG8_BAR; PG8_SCHED;
            PG8_LDA(At, 0, 1); PG8_STAGE(PG8_SB(0, 0), b2, voffB); PG8_STAGE(PG8_SB(0, 1), b2 + hstepB, voffB); PG8_STAGE(PG8_SA(0, 0), a2, voffA);
            PG8_WAIT_V(8); PG8_WAIT_L(0); PG8_BAR; PG8_MMA(1, 0, At, B0); PG8_MMA(1, 1, At, B1); PG8_BAR; PG8_SCHED;
            PG8_LDB(B0, 1, 0); PG8_LDB(B1, 1, 1); PG8_SCHED; PG8_LDA(At, 1, 0); PG8_STAGE(PG8_SA(0, 1), a2 + hstepA, voffA);
            PG8_WAIT_V(8); PG8_WAIT_L(0); PG8_BAR; PG8_MMA(0, 0, At, B0); PG8_MMA(0, 1, At, B1); PG8_BAR; PG8_SCHED;
            PG8_LDA(At, 1, 1); PG8_STAGE(PG8_SB(1, 0), b3, voffB); PG8_STAGE(PG8_SB(1, 1), b3 + hstepB, voffB); PG8_STAGE(PG8_SA(1, 0), a3, voffA);
            PG8_WAIT_V(8); PG8_WAIT_L(0); PG8_BAR; PG8_MMA(1, 0, At, B0); PG8_MMA(1, 1, At, B1); PG8_BAR; PG8_SCHED;
        }
        if (wr == 0) PG8_BAR;
        E(acc, cur, wr, wc, fr, fq);
        if (!has_next) break;
#pragma unroll
        for (int a = 0; a < 2; ++a)
#pragma unroll
            for (int b = 0; b < 2; ++b)
#pragma unroll
                for (int m = 0; m < 4; ++m)
#pragma unroll
                    for (int n = 0; n < 2; ++n) acc[a][b][m][n] = (f32x4){0.f, 0.f, 0.f, 0.f};
        cur = nxt; cA = nA; cB = nB; ++ui;
        if (wr == 1) PG8_BAR;
    }
    PG8_WAIT_V(0);
    PG8_BAR;
#undef PG8_SA
#undef PG8_SB
#undef PG8_STAGE
#undef PG8_LDA
#undef PG8_LDB
#undef PG8_MMA
#undef PG8_WAIT_V
#undef PG8_WAIT_L
#undef PG8_BAR
#undef PG8_SCHED
}

struct Epi {
    static constexpr bool PERM = true;
    int mode, l; bf16_t* o16; bf16_t* g16; float* f32; const float* bias; float* nak; float* nav;
    __device__ __forceinline__ void operator()(const f32x4 (&acc)[2][2][4][2], const Unit& u, int wr, int wc, int fr, int fq) const {
        const int row0 = u.pm * BM + wr * 64 + fr, colt = wc * 32 + 8 * fq;
        const bool gate_tile = (mode == 0) && (u.pn >= 12);
        f32x4 bv[2][2];
#pragma unroll
        for (int bj = 0; bj < 2; ++bj)
#pragma unroll
            for (int n = 0; n < 2; ++n) bv[bj][n] = gate_tile ? *(const f32x4*)(bias + (u.pn - 12) * BM + colt + bj * HALF + 4 * n) : (f32x4){0.f, 0.f, 0.f, 0.f};
        const bool wna = (mode == 0) && (u.pn == 9 || u.pn == 10) && u.pm < 16;
        float* nbase = nak + ((u.pn == 9) ? (ptrdiff_t)0 : (nav - nak));
#pragma unroll
        for (int ai = 0; ai < 2; ++ai)
#pragma unroll
            for (int m = 0; m < 4; ++m) { const int row = row0 + ai * HALF + m * 16;
#pragma unroll
                for (int bj = 0; bj < 2; ++bj) {
                    f32x4 v0 = acc[ai][bj][m][0], v1 = acc[ai][bj][m][1];
                    const int ct = colt + bj * HALF;
                    if (mode == 2) { bf16_t* d = (bf16_t*)f32 + (size_t)u.tag * ((size_t)T_ALL * DM) + (size_t)row * DM + u.pn * BM + ct;
                        u32x4 w; w.x = pk2(v0[0], v0[1]); w.y = pk2(v0[2], v0[3]); w.z = pk2(v1[0], v1[1]); w.w = pk2(v1[2], v1[3]); *(u32x4*)d = w; continue; }
                    size_t oidx;
                    if (mode == 0) {
                        if (gate_tile) { v0 += bv[bj][0]; v1 += bv[bj][1];
#pragma unroll
                            for (int j = 0; j < 4; ++j) { v0[j] = sigmoidf_(v0[j]); v1[j] = sigmoidf_(v1[j]); }
                            oidx = (size_t)row * NGATE + (u.pn - 12) * BM + ct;
                        } else {
                            oidx = (size_t)row * NPROJ + u.pn * BM + ct;
                            if (wna) { float* d = nbase + ((size_t)((u.pm * 4 + l) * 256 + (row & 255)) * 256 + ct); *(f32x4*)d = v0; *(f32x4*)(d + 4) = v1; }
                        }
                    } else {
                        if (mode == 3) {
#pragma unroll
                        for (int j = 0; j < 4; ++j) { const float a = fmaxf(v0[j], 0.f), b = fmaxf(v1[j], 0.f); v0[j] = a * a; v1[j] = b * b; } }
                        oidx = (size_t)row * DFF + u.pn * BM + ct;
                    }
                    u32x4 w; w.x = pk2(v0[0], v0[1]); w.y = pk2(v0[2], v0[3]); w.z = pk2(v1[0], v1[1]); w.w = pk2(v1[2], v1[3]);
                    const ptrdiff_t gdelta = g16 - o16;
                    *(u32x4*)(o16 + (oidx + (gate_tile ? gdelta : (ptrdiff_t)0))) = w;
                }
                asm volatile("" ::: "memory"); }
    }
};
}

__device__ __forceinline__ void transpose_item(const float* W, int N, bf16_t* WT, int ldk, int dstrow0, int k0, int n0, LAS float* scr, int lane) {
#pragma unroll 8
    for (int i = 0; i < 32; ++i) { const int kk = 2 * i + (lane >> 5); scr[kk * 33 + (lane & 31)] = W[(size_t)(k0 + kk) * N + n0 + (lane & 31)]; }
    LDS_WAIT();
    const int c = lane & 7;
#pragma unroll
    for (int j = 0; j < 4; ++j) { const int n = (lane >> 3) + 8 * j; const LAS float* s = scr + (8 * c) * 33 + n;
        u32x4 o; o.x = pk2(s[0 * 33], s[1 * 33]); o.y = pk2(s[2 * 33], s[3 * 33]); o.z = pk2(s[4 * 33], s[5 * 33]); o.w = pk2(s[6 * 33], s[7 * 33]);
        *(u32x4*)(WT + (size_t)(dstrow0 + n) * ldk + k0 + 8 * c) = o; }
    LDS_WAIT();
}

__device__ __forceinline__ void phase0(const Params& p, LAS unsigned char* lds) {
    const int tid = get_tid(), lane = tid & 63, wave = tid >> 6;
    const int G = get_nb();
    if (get_bid() == 0 && tid < N_IN) ((const float**)(p.ws + WS_TAB))[tid] = p.in[tid];
    {
        LAS float* svec = (LAS float*)lds;
        LAS float* red = (LAS float*)(lds + 20480);
        bool have = false;
        for (int it = get_bid(); it < 384; it += G) {
            if (!have) {
                for (int i = tid; i < 5 * 1024; i += 512) { const int j = i >> 10, k = i & 1023; const float v = (j == 0) ? PIN(I_CCTX)[k] : PIN(I_C)[(j - 1) * 1024 + k]; svec[i] = siluf_(v); }
                __syncthreads(); have = true;
            }
            const int l = it / 96, cch = it % 96, cq = tid & 15, ks = tid >> 4, col = cch * 64 + cq * 4;
            f32x4 a0 = {0, 0, 0, 0}, a1 = a0, a2 = a0, a3 = a0, a4 = a0;
            const float* wp = PIN(I_WADA) + ((size_t)l * 1024 + ks * 32) * 6144 + col;
#pragma unroll 4
            for (int k = 0; k < 32; ++k) { const f32x4 w = *(const f32x4*)(wp + (size_t)k * 6144); const int kk = ks * 32 + k;
                a0 += svec[kk] * w; a1 += svec[1024 + kk] * w; a2 += svec[2048 + kk] * w; a3 += svec[3072 + kk] * w; a4 += svec[4096 + kk] * w; }
            LAS float* rp = red + ks * 320 + cq * 4;
#pragma unroll
            for (int e = 0; e < 4; ++e) { rp[e] = a0[e]; rp[64 + e] = a1[e]; rp[128 + e] = a2[e]; rp[192 + e] = a3[e]; rp[256 + e] = a4[e]; }
            __syncthreads();
            if (tid < 320) { float s = 0.f;
#pragma unroll 8
                for (int k = 0; k < 32; ++k) s += red[k * 320 + tid];
                const int j = tid >> 6, cc = tid & 63;
                ((float*)(p.ws + WS_MOD))[(size_t)(l * 5 + j) * 6144 + cch * 64 + cc] = s + PIN(I_BADA)[l * 6144 + cch * 64 + cc]; }
            __syncthreads();
        }
        __syncthreads();
    }
    {
        LAS float* scr = (LAS float*)(lds + wave * 8448);
        const int gw = get_bid() * 8 + wave, NGW = G * 8;
        constexpr int I_IN = 16 * 89, I_MG = 16 * 128, I_BRN = 4 * 32, I_BR = 4 * I_BRN, I_OUT = 16 * 32, I_M1 = 16 * 128, I_M2 = 64 * 32, I_GLU = 4 * 16;
        constexpr int I_LAYER = I_IN + I_MG + I_BR + I_OUT + I_M1 + I_M2 + I_GLU;
        for (int it = gw; it < 4 * I_LAYER; it += NGW) {
            const int l = it / I_LAYER; int r = it % I_LAYER;
            unsigned char* wl = p.ws + WS_W + (size_t)l * WL_STRIDE;
            if (r < I_IN) { const int kb = r / 89, nb = r % 89, n0 = nb * 32; const int dr = (n0 < 2048) ? n0 : (n0 == 2048 ? C_GLR : n0 - 32);
                transpose_item(PIN(I_WIN) + (size_t)l * 1024 * 2848, 2848, (bf16_t*)(wl + WL_CAT), 1024, dr, kb * 64, n0, scr, lane); continue; } r -= I_IN;
            if (r < I_MG) { const int kb = r / 128, nb = r % 128;
                transpose_item(PIN(I_WMG) + (size_t)l * 1024 * 4096, 4096, (bf16_t*)(wl + WL_CAT), 1024, 3072 + nb * 32, kb * 64, nb * 32, scr, lane); continue; } r -= I_MG;
            if (r < I_BR) { const int n = r / I_BRN, rr = r % I_BRN, kb = rr / 32, nb = rr % 32;
                transpose_item(PIN(I_WBR) + ((size_t)l * 4 + n) * 256 * 1024, 1024, (bf16_t*)(wl + WL_BR), 256, n * 1024 + nb * 32, kb * 64, nb * 32, scr, lane); continue; } r -= I_BR;
            if (r < I_OUT) { const int kb = r / 32, nb = r % 32;
                transpose_item(PIN(I_WOUT) + (size_t)l * 1024 * 1024, 1024, (bf16_t*)(wl + WL_OUT), 1024, nb * 32, kb * 64, nb * 32, scr, lane); continue; } r -= I_OUT;
            if (r < I_M1) { const int kb = r / 128, nb = r % 128;
                transpose_item(PIN(I_W1) + (size_t)l * 1024 * 4096, 4096, (bf16_t*)(wl + WL_M1), 1024, nb * 32, kb * 64, nb * 32, scr, lane); continue; } r -= I_M1;
            if (r < I_M2) { const int kb = r / 32, nb = r % 32;
                transpose_item(PIN(I_W2) + (size_t)l * 4096 * 1024, 1024, (bf16_t*)(wl + WL_M2), 4096, nb * 32, kb * 64, nb * 32, scr, lane); continue; } r -= I_M2;
            { const int kb = r / 16, nb = r % 16;
                transpose_item(PIN(I_S5WG) + (size_t)l * 256 * 512, 512, (bf16_t*)(wl + WL_GLU), 256, nb * 32, kb * 64, nb * 32, scr, lane); }
        }
        const int gt = get_bid() * 512 + tid, NT = G * 512;
        for (int i = gt; i < 4 * 28672; i += NT) { const int l = i / 28672, o = i % 28672;
            *(u32x4*)(p.ws + WS_W + (size_t)l * WL_STRIDE + WL_CAT + (size_t)2848 * 2048 + (size_t)o * 16) = (u32x4){0u, 0u, 0u, 0u}; }
    }
}

__device__ __forceinline__ void row_phase(const Ctx& p, int l, int mode) {
    const int tid = get_tid(), lane = tid & 63, wave = tid >> 6;
    const int gw = get_bid() * 8 + wave, NGW = get_nb() * 8;
    float* xbuf = p.out + O_X;
    const bf16_t* part = (const bf16_t*)(p.ws + WS_PART);
    const float* mod = (const float*)(p.ws + WS_MOD);
    bf16_t* H = (bf16_t*)(p.ws + WS_H);
    for (int row = gw; row < T_ALL; row += NGW) {
        const int mj = (row < T_CTX) ? 0 : 1 + ((row - T_CTX) >> 10);
        f32x4 x[4];
        if (mode == 0 && l == 0) {
            const float* src = (row < T_CTX) ? PIN(I_XP) + (size_t)row * DM : PIN(I_XS) + (size_t)(row - T_CTX) * DM;
#pragma unroll
            for (int j = 0; j < 4; ++j) x[j] = *(const f32x4*)(src + 256 * j + 4 * lane);
        } else {
            const int lp = (mode == 0) ? l - 1 : l, np = (mode == 0) ? 3 : 1, gsl = (mode == 0) ? 5 : 2;
            f32x4 f[4]; float ss = 0.f;
#pragma unroll
            for (int j = 0; j < 4; ++j) { const u32x2 pa = *(const u32x2*)(part + (size_t)row * DM + 256 * j + 4 * lane), pb = *(const u32x2*)(part + (size_t)(T_ALL + row) * DM + 256 * j + 4 * lane);
                f[j] = (f32x4){bflo(pa.x) + bflo(pb.x), bfhi(pa.x) + bfhi(pb.x), bflo(pa.y) + bflo(pb.y), bfhi(pa.y) + bfhi(pb.y)};
                ss += (f[j][0] * f[j][0] + f[j][1] * f[j][1]) + (f[j][2] * f[j][2] + f[j][3] * f[j][3]); }
            const float rstd = rsqrtf(wave_sum(ss) * (1.f / DM) + EPS);
#pragma unroll
            for (int j = 0; j < 4; ++j) { const int col = 256 * j + 4 * lane;
                const f32x4 gn = *(const f32x4*)(PIN(I_GN) + (size_t)(lp * 4 + np) * DM + col);
                const f32x4 gt = *(const f32x4*)(mod + (size_t)(lp * 5 + mj) * 6144 + gsl * DM + col);
                x[j] = *(const f32x4*)(xbuf + (size_t)row * DM + col) + gt * (f[j] * rstd * gn); }
        }
#pragma unroll
        for (int j = 0; j < 4; ++j) *(f32x4*)(xbuf + (size_t)row * DM + 256 * j + 4 * lane) = x[j];
        if (!(mode == 0 && l == 4)) {
            float ss = 0.f;
#pragma unroll
            for (int j = 0; j < 4; ++j) ss += (x[j][0] * x[j][0] + x[j][1] * x[j][1]) + (x[j][2] * x[j][2] + x[j][3] * x[j][3]);
            const float rstd = rsqrtf(wave_sum(ss) * (1.f / DM) + EPS);
            const int nh = (mode == 0) ? 0 : 2, shs = (mode == 0) ? 0 : 3, scs = (mode == 0) ? 1 : 4;
#pragma unroll
            for (int j = 0; j < 4; ++j) { const int col = 256 * j + 4 * lane;
                const f32x4 gn = *(const f32x4*)(PIN(I_GN) + (size_t)(l * 4 + nh) * DM + col);
                const f32x4 sh = *(const f32x4*)(mod + (size_t)(l * 5 + mj) * 6144 + shs * DM + col);
                const f32x4 sc = *(const f32x4*)(mod + (size_t)(l * 5 + mj) * 6144 + scs * DM + col);
                const f32x4 hv = (x[j] * rstd * gn) * (1.f + sc) + sh;
                u32x2 o; o.x = pk2(hv[0], hv[1]); o.y = pk2(hv[2], hv[3]);
                *(u32x2*)(H + (size_t)row * DM + col) = o; }
        }
    }
}

__device__ __forceinline__ void rope8(const float (&x)[8], const float (&xp)[8], int d0, int s, float (&o)[8]) {
    const float pos = (float)((d0 < 32) ? (s >> 6) : (s & 63));
    const float sgn = (d0 & 16) ? 1.f : -1.f;
#pragma unroll
    for (int e = 0; e < 8; ++e) { const int f = (d0 & 15) + e; const float ang = pos * exp2f(-0.8304820237f * (float)f);
        float sn, cs; __sincosf(ang, &sn, &cs); o[e] = x[e] * cs + sgn * xp[e] * sn; }
}
__device__ __forceinline__ void load_qk8(const bf16_t* proj, int t, int colbase, int d0, bool rope, int s, float (&o)[8]) {
    const bf16_t* rowp = proj + (size_t)t * NPROJ + colbase;
    float x[8]; unpack8(*(const u32x4*)(rowp + d0), x);
    if (!rope) {
#pragma unroll
        for (int e = 0; e < 8; ++e) o[e] = x[e];
        return;
    }
    float xp[8]; unpack8(*(const u32x4*)(rowp + (d0 ^ 16)), xp);
    rope8(x, xp, d0, s, o);
}

__device__ __forceinline__ int ret_sidx(int path, int b, int h, int dir, int c) { return path ? 512 + ((b * 4 + h) * 2 + dir) * 16 + c : ((b * 4 + h) * 2 + dir) * 4 + c; }

__device__ __forceinline__ void ret_state_item(const Ctx& p, int l, int path, int b, int h, int dir, LAS unsigned char* lds) {
    const int tid = get_tid(), lane = tid & 63, w = tid >> 6, r = lane & 15, q = lane >> 4;
    LAS bf16_t* KdT0 = (LAS bf16_t*)lds; LAS bf16_t* VT0 = KdT0 + 2 * 64 * 72;
    const bf16_t* proj = (const bf16_t*)(p.ws + WS_PROJ);
    bf16_t* rets = (bf16_t*)(p.ws + WS_RETS);
    const int nch = path ? 16 : 4, tok0 = path ? T_CTX + b * 1024 : b * 256;
    const float lg = PIN(I_RLD)[(l * 2 + dir) * 4 + h], cdec = __expf(lg * 64.f);
    const int rb = w >> 1, cb0 = (w & 1) * 2;
    f32x4 acc[2];
#pragma unroll
    for (int i = 0; i < 2; ++i)
#pragma unroll
        for (int e = 0; e < 4; ++e) { const int dv = rb * 16 + q * 4 + e, dk = (cb0 + i) * 16 + r;
            acc[i][e] = path ? PIN(I_SRET)[((size_t)(((b * 4 + l) * 2 + dir) * 4 + h) * 64 + dk) * 64 + dv] : 0.f; }
    const int j = tid >> 3, d0 = (tid & 7) * 8;
    u32x4 kraw, kpar, vraw;
    { const int c0 = dir ? nch - 1 : 0; const bf16_t* rp = proj + (size_t)(tok0 + c0 * 64 + j) * NPROJ + h * 64;
      kraw = *(const u32x4*)(rp + C_RK + d0); kpar = *(const u32x4*)(rp + C_RK + (d0 ^ 16)); vraw = *(const u32x4*)(rp + C_RV + d0); }
    for (int ci = 0; ci < nch; ++ci) {
        const int c = dir ? nch - 1 - ci : ci;
        bf16_t* sd = rets + (size_t)ret_sidx(path, b, h, dir, c) * 4096;
#pragma unroll
        for (int i = 0; i < 2; ++i)
#pragma unroll
            for (int e = 0; e < 4; ++e) sd[(rb * 16 + q * 4 + e) * 64 + (cb0 + i) * 16 + r] = f2bf(acc[i][e]);
        const int s = c * 64 + j;
        float kx[8], kp[8], kv[8], vv[8];
        unpack8(kraw, kx); unpack8(kpar, kp); unpack8(vraw, vv);
        if (path) rope8(kx, kp, d0, s, kv); else {
#pragma unroll
            for (int e = 0; e < 8; ++e) kv[e] = kx[e]; }
        if (ci + 1 < nch) { const int cn = dir ? nch - 2 - ci : ci + 1; const bf16_t* rp = proj + (size_t)(tok0 + cn * 64 + j) * NPROJ + h * 64;
            kraw = *(const u32x4*)(rp + C_RK + d0); kpar = *(const u32x4*)(rp + C_RK + (d0 ^ 16)); vraw = *(const u32x4*)(rp + C_RV + d0); }
        const float wj = 0.125f * __expf(lg * (float)(dir ? j : 63 - j));
        LAS bf16_t* KdT = KdT0 + (ci & 1) * (64 * 72); LAS bf16_t* VT = VT0 + (ci & 1) * (64 * 72);
#pragma unroll
        for (int e = 0; e < 8; ++e) { KdT[(d0 + e) * 72 + j] = f2bf(kv[e] * wj); VT[(d0 + e) * 72 + j] = f2bf(vv[e]); }
        __syncthreads();
#pragma unroll
        for (int i = 0; i < 2; ++i) { acc[i] *= cdec; acc[i] = mma_k<2>(VT, 72, rb * 16, 0, KdT, 72, (cb0 + i) * 16, 0, acc[i], lane); }
    }
    __syncthreads();
    if (!path) {
#pragma unroll
        for (int i = 0; i < 2; ++i)
#pragma unroll
            for (int e = 0; e < 4; ++e) { const int dv = rb * 16 + q * 4 + e, dk = (cb0 + i) * 16 + r;
                p.out[O_RET + ((size_t)(((b * 4 + l) * 2 + dir) * 4 + h) * 64 + dk) * 64 + dv] = acc[i][e]; }
    }
}

__device__ __forceinline__ void headnorm_store(const LAS float* O, const float* gn, const bf16_t* gaterow, bf16_t* dst, int tid) {
    const int i = tid >> 3, sub = tid & 7;
    float v[8]; float s = 0.f;
#pragma unroll
    for (int e = 0; e < 8; ++e) { v[e] = O[i * 65 + sub * 8 + e]; s += v[e]; }
    s += __shfl_xor(s, 1); s += __shfl_xor(s, 2); s += __shfl_xor(s, 4);
    const float mu = s * (1.f / 64.f); float qv = 0.f;
#pragma unroll
    for (int e = 0; e < 8; ++e) { v[e] -= mu; qv += v[e] * v[e]; }
    qv += __shfl_xor(qv, 1); qv += __shfl_xor(qv, 2); qv += __shfl_xor(qv, 4);
    const float rstd = rsqrtf(qv * (1.f / 64.f) + EPS);
    float g[8]; unpack8(*(const u32x4*)(gaterow + sub * 8), g);
    float o[8];
#pragma unroll
    for (int e = 0; e < 8; ++e) o[e] = v[e] * rstd * gn[sub * 8 + e] * siluf_(g[e]);
    *(u32x4*)(dst + sub * 8) = pack8(o);
}

__device__ __forceinline__ void ret_out_item(const Ctx& p, int l, int path, int b, int h, int c, LAS unsigned char* lds) {
    const int tid = get_tid(), lane = tid & 63, w = tid >> 6, r = lane & 15, q = lane >> 4;
    LAS bf16_t* Q = (LAS bf16_t*)lds; LAS bf16_t* Kk = Q + 64 * 72; LAS bf16_t* VT = Kk + 64 * 72; LAS bf16_t* P = VT + 64 * 72;
    LAS bf16_t* QD = P + 64 * 72; LAS bf16_t* ST = QD + 64 * 136; LAS float* O = (LAS float*)(ST + 64 * 136);
    const bf16_t* proj = (const bf16_t*)(p.ws + WS_PROJ);
    const bf16_t* rets = (const bf16_t*)(p.ws + WS_RETS);
    const int tok0 = path ? T_CTX + b * 1024 : b * 256;
    const float lgf = PIN(I_RLD)[(l * 2 + 0) * 4 + h], lgb = PIN(I_RLD)[(l * 2 + 1) * 4 + h];
    {
        const int j = tid >> 3, d0 = (tid & 7) * 8, s = c * 64 + j, t = tok0 + s;
        float qv[8], kv[8], vv[8];
        load_qk8(proj, t, C_RQ + h * 64, d0, path != 0, s, qv);
        load_qk8(proj, t, C_RK + h * 64, d0, path != 0, s, kv);
        unpack8(*(const u32x4*)(proj + (size_t)t * NPROJ + C_RV + h * 64 + d0), vv);
        const float qf = __expf(lgf * (float)(j + 1)), qb = __expf(lgb * (float)(64 - j));
        float t0[8], t1[8], t2[8];
#pragma unroll
        for (int e = 0; e < 8; ++e) { kv[e] *= 0.125f; t0[e] = qv[e] * qf; t1[e] = qv[e] * qb; t2[e] = vv[e]; }
        *(LAS u32x4*)(Q + j * 72 + d0) = pack8(qv);
        *(LAS u32x4*)(Kk + j * 72 + d0) = pack8(kv);
        *(LAS u32x4*)(QD + j * 136 + d0) = pack8(t0);
        *(LAS u32x4*)(QD + j * 136 + 64 + d0) = pack8(t1);
#pragma unroll
        for (int e = 0; e < 8; ++e) VT[(d0 + e) * 72 + j] = f2bf(t2[e]);
        const u32x4 sf = *(const u32x4*)(rets + (size_t)ret_sidx(path, b, h, 0, c) * 4096 + tid * 8);
        const u32x4 sb = *(const u32x4*)(rets + (size_t)ret_sidx(path, b, h, 1, c) * 4096 + tid * 8);
        *(LAS u32x4*)(ST + j * 136 + d0) = sf;
        *(LAS u32x4*)(ST + j * 136 + 64 + d0) = sb;
    }
    __syncthreads();
    const int rb = w >> 1, cb0 = (w & 1) * 2;
#pragma unroll
    for (int i = 0; i < 2; ++i) {
        f32x4 a = {0.f, 0.f, 0.f, 0.f};
        a = mma_k<2>(Q, 72, rb * 16, 0, Kk, 72, (cb0 + i) * 16, 0, a, lane);
#pragma unroll
        for (int e = 0; e < 4; ++e) { const int ii = rb * 16 + q * 4 + e, jj = (cb0 + i) * 16 + r;
            float wgt = 0.f;
            if (jj <= ii) wgt += __expf(lgf * (float)(ii - jj));
            if (jj >= ii) wgt += __expf(lgb * (float)(jj - ii));
            P[ii * 72 + jj] = f2bf(a[e] * wgt); }
    }
    __syncthreads();
#pragma unroll
    for (int i = 0; i < 2; ++i) {
        f32x4 a = {0.f, 0.f, 0.f, 0.f};
        a = mma_k<2>(P, 72, rb * 16, 0, VT, 72, (cb0 + i) * 16, 0, a, lane);
        a = mma_k<4>(QD, 136, rb * 16, 0, ST, 136, (cb0 + i) * 16, 0, a, lane);
#pragma unroll
        for (int e = 0; e < 4; ++e) O[(rb * 16 + q * 4 + e) * 65 + (cb0 + i) * 16 + r] = a[e];
    }
    __syncthreads();
    {
        const int i = tid >> 3, t = tok0 + c * 64 + i;
        headnorm_store(O, PIN(I_RGN) + l * 256 + h * 64, proj + (size_t)t * NPROJ + C_RG + h * 64, (bf16_t*)(p.ws + WS_BR) + (size_t)t * DM + 0 * 256 + h * 64, tid);
    }
    __syncthreads();
}

__device__ __forceinline__ void gla_cum(const Ctx& p, int l, int dir, int h, u32x4 lra, u32x4 lrb, LAS float* Bc, LAS float* BEND) {
    const int tid = get_tid(), lane = tid & 63, w = tid >> 6;
    {
        const int j = tid >> 3, dd = (tid & 7) * 4;
        float lr[16]; { float a[8], b2[8]; unpack8(lra, a); unpack8(lrb, b2);
#pragma unroll
            for (int e = 0; e < 8; ++e) { lr[e] = a[e]; lr[8 + e] = b2[e]; } }
        const float* wg = PIN(I_GWG) + (size_t)(l * 2 + dir) * 16 * 128 + h * 32 + dd;
        f32x4 z = *(const f32x4*)(PIN(I_GBG) + (l * 2 + dir) * 128 + h * 32 + dd);
#pragma unroll
        for (int rr = 0; rr < 16; ++rr) z += lr[rr] * *(const f32x4*)(wg + rr * 128);
#pragma unroll
        for (int e = 0; e < 4; ++e) { const float x = z[e]; const float ls = fminf(x, 0.f) - __logf(1.f + __expf(-fabsf(x))); Bc[j * 33 + dd + e] = ls * (1.f / 16.f); }
    }
    __syncthreads();
    {
        const int pos = dir ? 63 - lane : lane;
#pragma unroll
        for (int k = 0; k < 4; ++k) { const int d = w * 4 + k; float v = Bc[pos * 33 + d];
#pragma unroll
            for (int off = 1; off < 64; off <<= 1) { const float tv = __shfl_up(v, off); if (lane >= off) v += tv; }
            Bc[pos * 33 + d] = v; if (lane == 63) BEND[d] = v; }
    }
    __syncthreads();
}

__device__ __forceinline__ int gla_sidx(int path, int b, int h, int dir, int c) { return ret_sidx(path, b, h, dir, c); }

__device__ __forceinline__ void gla_state_item(const Ctx& p, int l, int path, int b, int h, int dir, LAS unsigned char* lds) {
    const int tid = get_tid(), lane = tid & 63, w = tid >> 6, r = lane & 15, q = lane >> 4;
    LAS bf16_t* KdT0 = (LAS bf16_t*)lds; LAS bf16_t* VT0 = KdT0 + 2 * 32 * 72; LAS float* Bc0 = (LAS float*)(VT0 + 2 * 64 * 72); LAS float* BEND0 = Bc0 + 2 * 64 * 33;
    const bf16_t* proj = (const bf16_t*)(p.ws + WS_PROJ);
    bf16_t* glas = (bf16_t*)(p.ws + WS_GLAS);
    const int nch = path ? 16 : 4, tok0 = path ? T_CTX + b * 1024 : b * 256;
    const int rb = w >> 1, cb = w & 1;
    f32x4 acc;
#pragma unroll
    for (int e = 0; e < 4; ++e) { const int dv = rb * 16 + q * 4 + e, dk = cb * 16 + r;
        acc[e] = path ? PIN(I_SGLA)[((size_t)(((b * 4 + l) * 2 + dir) * 4 + h) * 32 + dk) * 64 + dv] : 0.f; }
    const int j = tid >> 3, dd = (tid & 7) * 4, d0 = (tid & 7) * 8;
    u32x4 lra, lrb, vraw; u32x2 kw;
    { const int c0 = dir ? nch - 1 : 0; const bf16_t* rp = proj + (size_t)(tok0 + c0 * 64 + j) * NPROJ;
      lra = *(const u32x4*)(rp + C_GLR + dir * 16); lrb = *(const u32x4*)(rp + C_GLR + dir * 16 + 8); kw = *(const u32x2*)(rp + C_GK + h * 32 + dd); vraw = *(const u32x4*)(rp + C_GV + h * 64 + d0); }
    for (int ci = 0; ci < nch; ++ci) {
        const int c = dir ? nch - 1 - ci : ci;
        LAS bf16_t* KdT = KdT0 + (ci & 1) * (32 * 72); LAS bf16_t* VT = VT0 + (ci & 1) * (64 * 72); LAS float* Bc = Bc0 + (ci & 1) * (64 * 33); LAS float* BEND = BEND0 + (ci & 1) * 32;
        gla_cum(p, l, dir, h, lra, lrb, Bc, BEND);
        bf16_t* sd = glas + (size_t)gla_sidx(path, b, h, dir, c) * 2048;
#pragma unroll
        for (int e = 0; e < 4; ++e) sd[(rb * 16 + q * 4 + e) * 32 + cb * 16 + r] = f2bf(acc[e]);
        {
            const float kf[4] = {bflo(kw.x), bfhi(kw.x), bflo(kw.y), bfhi(kw.y)};
#pragma unroll
            for (int e = 0; e < 4; ++e) KdT[(dd + e) * 72 + j] = f2bf(kf[e] * __expf(BEND[dd + e] - Bc[j * 33 + dd + e]));
            float vv[8]; unpack8(vraw, vv);
#pragma unroll
            for (int e = 0; e < 8; ++e) VT[(d0 + e) * 72 + j] = f2bf(vv[e]);
        }
        if (ci + 1 < nch) { const int cn = dir ? nch - 2 - ci : ci + 1; const bf16_t* rp = proj + (size_t)(tok0 + cn * 64 + j) * NPROJ;
            lra = *(const u32x4*)(rp + C_GLR + dir * 16); lrb = *(const u32x4*)(rp + C_GLR + dir * 16 + 8); kw = *(const u32x2*)(rp + C_GK + h * 32 + dd); vraw = *(const u32x4*)(rp + C_GV + h * 64 + d0); }
        __syncthreads();
        acc *= __expf(BEND[cb * 16 + r]);
        acc = mma_k<2>(VT, 72, rb * 16, 0, KdT, 72, cb * 16, 0, acc, lane);
    }
    __syncthreads();
    if (!path) {
#pragma unroll
        for (int e = 0; e < 4; ++e) { const int dv = rb * 16 + q * 4 + e, dk = cb * 16 + r;
            p.out[O_GLA + ((size_t)(((b * 4 + l) * 2 + dir) * 4 + h) * 32 + dk) * 64 + dv] = acc[e]; }
    }
}

__device__ __forceinline__ void gla_out_item(const Ctx& p, int l, int path, int b, int h, int c, LAS unsigned char* lds) {
    const int tid = get_tid(), lane = tid & 63, w = tid >> 6, r = lane & 15, q = lane >> 4;
    LAS bf16_t* QD = (LAS bf16_t*)lds; LAS bf16_t* KD = QD + 64 * 72; LAS bf16_t* VT = KD + 64 * 72; LAS bf16_t* P = VT + 64 * 72; LAS bf16_t* ST = P + 64 * 72;
    LAS float* O = (LAS float*)(ST + 64 * 72); LAS float* BcF = O + 64 * 65; LAS float* BcB = BcF + 64 * 33; LAS float* BEND = BcB + 64 * 33;
    const bf16_t* proj = (const bf16_t*)(p.ws + WS_PROJ);
    const bf16_t* glas = (const bf16_t*)(p.ws + WS_GLAS);
    const int tok0 = path ? T_CTX + b * 1024 : b * 256, tc0 = tok0 + c * 64;
    { const bf16_t* rp = proj + (size_t)(tc0 + (tid >> 3)) * NPROJ + C_GLR; const u32x4 l0 = *(const u32x4*)rp, l1 = *(const u32x4*)(rp + 8), l2 = *(const u32x4*)(rp + 16), l3 = *(const u32x4*)(rp + 24);
      gla_cum(p, l, 0, h, l0, l1, BcF, BEND);
      gla_cum(p, l, 1, h, l2, l3, BcB, BEND); }
    {
        const int j = tid >> 3, t = tc0 + j, dd = (tid & 7) * 4;
        const u32x2 qw = *(const u32x2*)(proj + (size_t)t * NPROJ + C_GQ + h * 32 + dd);
        const u32x2 kw = *(const u32x2*)(proj + (size_t)t * NPROJ + C_GK + h * 32 + dd);
        const float qf[4] = {bflo(qw.x), bfhi(qw.x), bflo(qw.y), bfhi(qw.y)}, kf[4] = {bflo(kw.x), bfhi(kw.x), bflo(kw.y), bfhi(kw.y)};
        const float qs = 0.17677669529663687f;
        float a0[4], a1[4], a2[4], a3[4];
#pragma unroll
        for (int e = 0; e < 4; ++e) { const float bf_ = BcF[j * 33 + dd + e], bb_ = BcB[j * 33 + dd + e];
            a0[e] = qf[e] * qs * __expf(bf_); a1[e] = qf[e] * qs * __expf(bb_); a2[e] = kf[e] * __expf(-bf_); a3[e] = kf[e] * __expf(-bb_); }
        u32x2 o; o.x = pk2(a0[0], a0[1]); o.y = pk2(a0[2], a0[3]); *(LAS u32x2*)(QD + j * 72 + dd) = o;
        o.x = pk2(a1[0], a1[1]); o.y = pk2(a1[2], a1[3]); *(LAS u32x2*)(QD + j * 72 + 32 + dd) = o;
        o.x = pk2(a2[0], a2[1]); o.y = pk2(a2[2], a2[3]); *(LAS u32x2*)(KD + j * 72 + dd) = o;
        o.x = pk2(a3[0], a3[1]); o.y = pk2(a3[2], a3[3]); *(LAS u32x2*)(KD + j * 72 + 32 + dd) = o;
        const int d0 = (tid & 7) * 8; float vv[8]; unpack8(*(const u32x4*)(proj + (size_t)t * NPROJ + C_GV + h * 64 + d0), vv);
#pragma unroll
        for (int e = 0; e < 8; ++e) VT[(d0 + e) * 72 + j] = f2bf(vv[e]);
        const int dir = tid >> 8, idx = (tid & 255) * 8, dv = idx >> 5, dk0 = idx & 31;
        *(LAS u32x4*)(ST + dv * 72 + dir * 32 + dk0) = *(const u32x4*)(glas + (size_t)gla_sidx(path, b, h, dir, c) * 2048 + idx);
    }
    __syncthreads();
    const int rb = w >> 1, cb0 = (w & 1) * 2;
#pragma unroll
    for (int i = 0; i < 2; ++i) {
        f32x4 af = {0.f, 0.f, 0.f, 0.f}, ab = af;
        af = mma_k<1>(QD, 72, rb * 16, 0, KD, 72, (cb0 + i) * 16, 0, af, lane);
        ab = mma_k<1>(QD, 72, rb * 16, 32, KD, 72, (cb0 + i) * 16, 32, ab, lane);
#pragma unroll
        for (int e = 0; e < 4; ++e) { const int ii = rb * 16 + q * 4 + e, jj = (cb0 + i) * 16 + r;
            float v = 0.f; if (jj <= ii) v += af[e]; if (jj >= ii) v += ab[e];
            P[ii * 72 + jj] = f2bf(v); }
    }
    __syncthreads();
#pragma unroll
    for (int i = 0; i < 2; ++i) {
        f32x4 a = {0.f, 0.f, 0.f, 0.f};
        a = mma_k<2>(P, 72, rb * 16, 0, VT, 72, (cb0 + i) * 16, 0, a, lane);
        a = mma_k<2>(QD, 72, rb * 16, 0, ST, 72, (cb0 + i) * 16, 0, a, lane);
#pragma unroll
        for (int e = 0; e < 4; ++e) O[(rb * 16 + q * 4 + e) * 65 + (cb0 + i) * 16 + r] = a[e];
    }
    __syncthreads();
    {
        const int i = tid >> 3, t = tc0 + i;
        headnorm_store(O, PIN(I_GGN) + l * 256 + h * 64, proj + (size_t)t * NPROJ + C_GG + h * 64, (bf16_t*)(p.ws + WS_BR) + (size_t)t * DM + 2 * 256 + h * 64, tid);
    }
    __syncthreads();
}

__device__ __forceinline__ size_t s5e_idx(int slot, int dir, int g, int seg) { return ((size_t)((slot * 2 + dir) * 16 + g) * 16 + seg) * 128; }
__device__ __forceinline__ void s5_item(const Ctx& p, int l, int path, int b, int dir, int gset, int seg0, LAS unsigned char* lds) {
    const int tid = get_tid(), lane = tid & 63, w = tid >> 6, r = lane & 15, q = lane >> 4;
    const int g = gset * 8 + w;
    LAS unsigned char* wl = lds + w * 16384;
    LAS bf16_t* U = (LAS bf16_t*)wl;
    LAS float* BU = (LAS float*)(wl + 1280);
    LAS bf16_t* XS = (LAS bf16_t*)(wl + 1280 + 8448);
    const bf16_t* proj = (const bf16_t*)(p.ws + WS_PROJ);
    float* s5y = (float*)(p.ws + WS_S5Y) + (size_t)dir * T_ALL * 256;
    const int tokb = (path ? T_CTX + b * 1024 : b * 256);
    const int ldg = (l * 2 + dir) * 16 + g;
    const float dt = __expf(PIN(I_S5DT)[ldg]);
    float ar, ai;
    { const float lre = PIN(I_S5LR)[ldg * 64 + lane], lim = PIN(I_S5LI)[ldg * 64 + lane]; const float m = __expf(lre * dt); float sn, cs; sincosf(lim * dt, &sn, &cs); ar = m * cs; ai = m * sn; }
    bf16x8 bfrag[8];
#pragma unroll
    for (int ct = 0; ct < 8; ++ct) {
        const int ps = (ct & 3) * 16 + r;
        const float lre = PIN(I_S5LR)[ldg * 64 + ps], lim = PIN(I_S5LI)[ldg * 64 + ps];
        const float m = __expf(lre * dt); float sn, cs; sincosf(lim * dt, &sn, &cs);
        const float nr = m * cs - 1.f, ni = m * sn, den = 1.f / (lre * lre + lim * lim);
        const float cr = (nr * lre + ni * lim) * den, cim = (ni * lre - nr * lim) * den;
        float vals[8];
        if (q < 2) {
            const float* br = PIN(I_S5BR) + ((size_t)ldg * 64 + ps) * 16 + q * 8; const float* bi = PIN(I_S5BI) + ((size_t)ldg * 64 + ps) * 16 + q * 8;
#pragma unroll
            for (int e = 0; e < 8; ++e) vals[e] = (ct < 4) ? (cr * br[e] - cim * bi[e]) : (cr * bi[e] + cim * br[e]);
        } else {
#pragma unroll
            for (int e = 0; e < 8; ++e) vals[e] = 0.f;
        }
        const u32x4 pk = pack8(vals); bfrag[ct] = *(const bf16x8*)&pk;
    }
    bf16x8 cfrag[4];
#pragma unroll
    for (int ks = 0; ks < 4; ++ks) {
        const int k0 = ks * 32 + q * 8; float vals[8];
        const float* src = (k0 < 64) ? PIN(I_S5CR) + ((size_t)ldg * 16 + r) * 64 + k0 : PIN(I_S5CI) + ((size_t)ldg * 16 + r) * 64 + (k0 - 64);
#pragma unroll
        for (int e = 0; e < 8; ++e) vals[e] = (k0 < 64) ? src[e] : -src[e];
        const u32x4 pk = pack8(vals); cfrag[ks] = *(const bf16x8*)&pk;
    }
    for (int i = lane; i < 16 * 40; i += 64) U[i] = 0;
    LDS_WAIT();
#pragma unroll 1
    for (int sg = 0; sg < 4; ++sg) {
    const int seg = seg0 + sg, tok0 = tokb + seg * 64;
    float xr = 0.f, xi = 0.f;
    const int ujj = (lane & 31) >> 1, uhalf = lane & 1;
    u32x4 unext;
    { const int pp = ujj, ti = dir ? 63 - pp : pp; unext = *(const u32x4*)(proj + (size_t)(tok0 + ti) * NPROJ + C_SU + g * 16 + uhalf * 8); }
#pragma unroll 1
    for (int sc = 0; sc < 4; ++sc) {
        if (lane < 32) *(LAS u32x4*)(U + ujj * 40 + uhalf * 8) = unext;
        if (sc + 1 < 4) { const int pp = (sc + 1) * 16 + ujj, ti = dir ? 63 - pp : pp; unext = *(const u32x4*)(proj + (size_t)(tok0 + ti) * NPROJ + C_SU + g * 16 + uhalf * 8); }
        LDS_WAIT();
        const bf16x8 afr = *(const LAS bf16x8*)(U + r * 40 + q * 8);
#pragma unroll
        for (int ct = 0; ct < 8; ++ct) { f32x4 a = {0.f, 0.f, 0.f, 0.f}; a = __builtin_amdgcn_mfma_f32_16x16x32_bf16(afr, bfrag[ct], a, 0, 0, 0);
#pragma unroll
            for (int e = 0; e < 4; ++e) BU[(q * 4 + e) * 132 + ct * 16 + r] = a[e]; }
        LDS_WAIT();
#pragma unroll
        for (int jj = 0; jj < 16; ++jj) { const float bur = BU[jj * 132 + lane], bui = BU[jj * 132 + 64 + lane];
            const float nr = ar * xr - ai * xi + bur, ni = ar * xi + ai * xr + bui; xr = nr; xi = ni;
            XS[jj * 136 + lane] = f2bf(xr); XS[jj * 136 + 64 + lane] = f2bf(xi); }
        LDS_WAIT();
        f32x4 y = {0.f, 0.f, 0.f, 0.f};
#pragma unroll
        for (int ks = 0; ks < 4; ++ks) { const bf16x8 xa = *(const LAS bf16x8*)(XS + r * 136 + ks * 32 + q * 8); y = __builtin_amdgcn_mfma_f32_16x16x32_bf16(xa, cfrag[ks], y, 0, 0, 0); }
#pragma unroll
        for (int e = 0; e < 4; ++e) { const int pp = sc * 16 + q * 4 + e, ti = dir ? 63 - pp : pp; s5y[(size_t)(tok0 + ti) * 256 + g * 16 + r] = y[e]; }
        LDS_WAIT();
    }
    { float* d = (float*)(p.ws + WS_S5E) + s5e_idx(path ? 16 + b : b, dir, g, seg) + lane * 2; d[0] = xr; d[1] = xi; }
    }

}

__device__ __forceinline__ void s5_glu_item(const Ctx& p, int l, int tile, LAS unsigned char* lds) {
    const int tid = get_tid(), lane = tid & 63, w = tid >> 6, r = lane & 15, q = lane >> 4;
    LAS bf16_t* GA = (LAS bf16_t*)lds;
    LAS bf16_t* Zw = GA + 64 * 264 + w * (16 * 136);
    const bf16_t* proj = (const bf16_t*)(p.ws + WS_PROJ);
    const float* yf = (const float*)(p.ws + WS_S5Y); const float* yb = yf + (size_t)T_ALL * 256;
    const float* s5e = (const float*)(p.ws + WS_S5E);
    const int t0 = tile * 64;
    const int path = tile >= 64 ? 1 : 0, tl = tile - 64;
    const int b = path ? tl >> 4 : tile >> 2, seg = path ? tl & 15 : tile & 3, nseg = path ? 16 : 4, slot = path ? 16 + b : b;
    f32x4 yc[2][4];
#pragma unroll
    for (int gi = 0; gi < 2; ++gi)
#pragma unroll
        for (int pc = 0; pc < 4; ++pc) yc[gi][pc] = (f32x4){0.f, 0.f, 0.f, 0.f};
#pragma unroll
    for (int gi = 0; gi < 2; ++gi) {
        const int g = 2 * w + gi;
#pragma unroll
        for (int dir = 0; dir < 2; ++dir) {
            const int ldg = (l * 2 + dir) * 16 + g;
            const float dt = __expf(PIN(I_S5DT)[ldg]);
            const float lre = PIN(I_S5LR)[ldg * 64 + lane], lim = PIN(I_S5LI)[ldg * 64 + lane];
            float ar, ai, ar64, ai64;
            { const float m = __expf(lre * dt); float sn, cs; sincosf(lim * dt, &sn, &cs); ar = m * cs; ai = m * sn; }
            { const float m = __expf(64.f * lre * dt); float sn, cs; sincosf(64.f * lim * dt, &sn, &cs); ar64 = m * cs; ai64 = m * sn; }
            float xr = 0.f, xi = 0.f;
            if (path) { const float* s0 = PIN(I_SS5) + ((size_t)(((b * 4 + l) * 2 + dir) * 16 + g) * 64 + lane) * 2; xr = s0[0]; xi = s0[1]; }
            const int nprev = dir ? nseg - 1 - seg : seg;
            { float er[15], ei[15];
#pragma unroll
              for (int k = 0; k < 15; ++k) { er[k] = 0.f; ei[k] = 0.f;
                  if (k < nprev) { const int sg = dir ? nseg - 1 - k : k; const float2 e = *(const float2*)(s5e + s5e_idx(slot, dir, g, sg) + lane * 2); er[k] = e.x; ei[k] = e.y; } }
#pragma unroll
              for (int k = 0; k < 15; ++k) if (k < nprev) { const float nr = ar64 * xr - ai64 * xi + er[k], ni = ar64 * xi + ai64 * xr + ei[k]; xr = nr; xi = ni; } }
            if (!path && seg == (dir ? 0 : nseg - 1)) {
                const float* e = s5e + s5e_idx(slot, dir, g, seg) + lane * 2;
                float* d = p.out + O_S5 + ((size_t)(((b * 4 + l) * 2 + dir) * 16 + g) * 64 + lane) * 2;
                d[0] = ar64 * xr - ai64 * xi + e[0]; d[1] = ar64 * xi + ai64 * xr + e[1]; }
            bf16x8 cfrag[4];
#pragma unroll
            for (int ks = 0; ks < 4; ++ks) {
                const int k0 = ks * 32 + q * 8; float vals[8];
                const float* src = (k0 < 64) ? PIN(I_S5CR) + ((size_t)ldg * 16 + r) * 64 + k0 : PIN(I_S5CI) + ((size_t)ldg * 16 + r) * 64 + (k0 - 64);
#pragma unroll
                for (int e = 0; e < 8; ++e) vals[e] = (k0 < 64) ? src[e] : -src[e];
                const u32x4 pk = pack8(vals); cfrag[ks] = *(const bf16x8*)&pk;
            }
            float zr = xr, zi = xi;
#pragma unroll
            for (int ppc = 0; ppc < 4; ++ppc) {
#pragma unroll 4
                for (int pj = 0; pj < 16; ++pj) { const float nr = ar * zr - ai * zi, ni = ar * zi + ai * zr; zr = nr; zi = ni;
                    const int row = dir ? 15 - pj : pj; Zw[row * 136 + lane] = f2bf(zr); Zw[row * 136 + 64 + lane] = f2bf(zi); }
                LDS_WAIT();
                f32x4 y = yc[gi][dir ? 3 - ppc : ppc];
#pragma unroll
                for (int ks = 0; ks < 4; ++ks) { const bf16x8 xa = *(const LAS bf16x8*)(Zw + r * 136 + ks * 32 + q * 8); y = __builtin_amdgcn_mfma_f32_16x16x32_bf16(xa, cfrag[ks], y, 0, 0, 0); }
                yc[gi][dir ? 3 - ppc : ppc] = y;
                LDS_WAIT();
            }
        }
    }
#pragma unroll
    for (int gi = 0; gi < 2; ++gi) {
        const int c = (2 * w + gi) * 16 + r; const float dsk = PIN(I_S5D)[l * 256 + c];
#pragma unroll
        for (int pc = 0; pc < 4; ++pc)
#pragma unroll
            for (int e = 0; e < 4; ++e) { const int i = pc * 16 + q * 4 + e, t = t0 + i;
                const float u = bf2f(proj[(size_t)t * NPROJ + C_SU + c]);
                const float y = yf[(size_t)t * 256 + c] + yb[(size_t)t * 256 + c] + yc[gi][pc][e] + dsk * u;
                const float inner = 0.7978845608028654f * (y + 0.044715f * y * y * y);
                GA[i * 264 + c] = f2bf(0.5f * y * (1.f + tanhf(inner))); }
    }
    __syncthreads();
    const bf16_t* wglu = (const bf16_t*)(p.ws + WS_W + (size_t)l * WL_STRIDE + WL_GLU);
    bf16_t* br = (bf16_t*)(p.ws + WS_BR);
#pragma unroll 1
    for (int ci = 0; ci < 2; ++ci) {
        const int cb = w + ci * 8;
        bf16x8 wa[8], wg[8];
#pragma unroll
        for (int ks = 0; ks < 8; ++ks) { wa[ks] = *(const bf16x8*)(wglu + (size_t)(cb * 16 + r) * 256 + ks * 32 + q * 8); wg[ks] = *(const bf16x8*)(wglu + (size_t)(256 + cb * 16 + r) * 256 + ks * 32 + q * 8); }
        const float ba = PIN(I_S5BG)[l * 512 + cb * 16 + r], bg = PIN(I_S5BG)[l * 512 + 256 + cb * 16 + r];
#pragma unroll 1
        for (int rb = 0; rb < 4; ++rb) {
            f32x4 aa = {0.f, 0.f, 0.f, 0.f}, ag = aa;
#pragma unroll
            for (int ks = 0; ks < 8; ++ks) { const bf16x8 af = *(const LAS bf16x8*)(GA + (rb * 16 + r) * 264 + ks * 32 + q * 8);
                aa = __builtin_amdgcn_mfma_f32_16x16x32_bf16(af, wa[ks], aa, 0, 0, 0); ag = __builtin_amdgcn_mfma_f32_16x16x32_bf16(af, wg[ks], ag, 0, 0, 0); }
#pragma unroll
            for (int e = 0; e < 4; ++e) { const int t = t0 + rb * 16 + q * 4 + e; br[(size_t)t * DM + 256 + cb * 16 + r] = f2bf((aa[e] + ba) * sigmoidf_(ag[e] + bg)); }
        }
    }
    __syncthreads();
}

__device__ __forceinline__ void na_item(const Ctx& p, int l, int kind, int b, int h, int qt, LAS unsigned char* lds) {
    const int tid = get_tid(), lane = tid & 63, w = tid >> 6, r = lane & 15, q = lane >> 4;
    LAS bf16_t* Qs = (LAS bf16_t*)lds; LAS bf16_t* Ks = Qs + 64 * 72; LAS bf16_t* VTs = Ks + 64 * 72; LAS bf16_t* Pb = VTs + 64 * 72;
    LAS float* Sb = (LAS float*)(Pb + 64 * 72); LAS float* ALPHA = Sb + 64 * 68; LAS float* LSUM = ALPHA + 64;
    const bf16_t* proj = (const bf16_t*)(p.ws + WS_PROJ);
    const int tq0 = kind ? T_CTX + b * 1024 + qt * 64 : b * 256 + qt * 64;
    const int nblk = kind ? 12 : 4;
    const int rs = kind ? min(max(qt - 4, 0), 8) : 0;
    const int j = tid >> 3, d0 = (tid & 7) * 8;
    *(LAS u32x4*)(Qs + j * 72 + d0) = *(const u32x4*)(proj + (size_t)(tq0 + j) * NPROJ + C_NQ + h * 64 + d0);
    const int rb = w >> 1, cb0 = (w & 1) * 2;
    f32x4 oacc[2] = {{0.f, 0.f, 0.f, 0.f}, {0.f, 0.f, 0.f, 0.f}};
    float mrun = -1e30f, lrun = 0.f;
    const float* rpb = PIN(I_RPB) + (size_t)(l * 4 + h) * 15 * 31;
    auto loadkv = [&](int blk, u32x4& kreg, u32x4& vreg) {
        if (kind == 0 || blk < 8) {
            const int tk = kind ? T_CTX + b * 1024 + (rs + blk) * 64 + j : b * 256 + blk * 64 + j;
            kreg = *(const u32x4*)(proj + (size_t)tk * NPROJ + C_NK + h * 64 + d0);
            vreg = *(const u32x4*)(proj + (size_t)tk * NPROJ + C_NV + h * 64 + d0);
        } else {
            const size_t off = ((size_t)((b * 4 + l) * 256 + (blk - 8) * 64 + j) * 4 + h) * 64 + d0;
            const f32x4 k0 = *(const f32x4*)(PIN(I_CK) + off), k1 = *(const f32x4*)(PIN(I_CK) + off + 4);
            const f32x4 v0 = *(const f32x4*)(PIN(I_CV) + off), v1 = *(const f32x4*)(PIN(I_CV) + off + 4);
            kreg.x = pk2(k0[0], k0[1]); kreg.y = pk2(k0[2], k0[3]); kreg.z = pk2(k1[0], k1[1]); kreg.w = pk2(k1[2], k1[3]);
            vreg.x = pk2(v0[0], v0[1]); vreg.y = pk2(v0[2], v0[3]); vreg.z = pk2(v1[0], v1[1]); vreg.w = pk2(v1[2], v1[3]);
        }
    };
    u32x4 knext, vnext;
    loadkv(0, knext, vnext);
    for (int blk = 0; blk < nblk; ++blk) {
        const u32x4 kreg = knext, vreg = vnext;
        *(LAS u32x4*)(Ks + j * 72 + d0) = kreg;
        if (blk + 1 < nblk) loadkv(blk + 1, knext, vnext);
        { const unsigned vw[4] = {vreg.x, vreg.y, vreg.z, vreg.w};
#pragma unroll
            for (int e = 0; e < 4; ++e) { VTs[(d0 + 2 * e) * 72 + j] = (bf16_t)(vw[e] & 0xffffu); VTs[(d0 + 2 * e + 1) * 72 + j] = (bf16_t)(vw[e] >> 16); } }
        __syncthreads();
        const bool local = kind && blk < 8;
#pragma unroll
        for (int i = 0; i < 2; ++i) {
            f32x4 a = {0.f, 0.f, 0.f, 0.f};
            a = mma_k<2>(Qs, 72, rb * 16, 0, Ks, 72, (cb0 + i) * 16, 0, a, lane);
#pragma unroll
            for (int e = 0; e < 4; ++e) { const int qi = rb * 16 + q * 4 + e, kc = (cb0 + i) * 16 + r;
                float sv = a[e] * 0.125f;
                if (local) { const int cs = min(max(qi - 8, 0), 48); const int ridx = rs + blk - qt + 7, cidx = min(max(kc - qi + 15, 0), 30);
                    sv = (kc >= cs && kc < cs + 16) ? sv + rpb[ridx * 31 + cidx] : -1e30f; }
                Sb[qi * 68 + kc] = sv; }
        }
        __syncthreads();
        {
            const int sub = tid & 7;
            const f32x4 s0 = *(const LAS f32x4*)(Sb + j * 68 + sub * 8), s1 = *(const LAS f32x4*)(Sb + j * 68 + sub * 8 + 4);
            float bm = fmaxf(fmaxf(fmaxf(s0[0], s0[1]), fmaxf(s0[2], s0[3])), fmaxf(fmaxf(s1[0], s1[1]), fmaxf(s1[2], s1[3])));
            bm = fmaxf(bm, __shfl_xor(bm, 1)); bm = fmaxf(bm, __shfl_xor(bm, 2)); bm = fmaxf(bm, __shfl_xor(bm, 4));
            const float mnew = fmaxf(mrun, bm), alpha = __expf(mrun - mnew);
            float pv[8];
#pragma unroll
            for (int e = 0; e < 4; ++e) { pv[e] = __expf(s0[e] - mnew); pv[4 + e] = __expf(s1[e] - mnew); }
            float ps = ((pv[0] + pv[1]) + (pv[2] + pv[3])) + ((pv[4] + pv[5]) + (pv[6] + pv[7]));
            ps += __shfl_xor(ps, 1); ps += __shfl_xor(ps, 2); ps += __shfl_xor(ps, 4);
            lrun = lrun * alpha + ps; mrun = mnew;
            *(LAS u32x4*)(Pb + j * 72 + sub * 8) = pack8(pv);
            if (sub == 0) ALPHA[j] = alpha;
        }
        __syncthreads();
#pragma unroll
        for (int i = 0; i < 2; ++i) {
#pragma unroll
            for (int e = 0; e < 4; ++e) oacc[i][e] *= ALPHA[rb * 16 + q * 4 + e];
            oacc[i] = mma_k<2>(Pb, 72, rb * 16, 0, VTs, 72, (cb0 + i) * 16, 0, oacc[i], lane);
        }
        __syncthreads();
    }
    if ((tid & 7) == 0) LSUM[j] = lrun;
    __syncthreads();
    bf16_t* br = (bf16_t*)(p.ws + WS_BR);
#pragma unroll
    for (int i = 0; i < 2; ++i)
#pragma unroll
        for (int e = 0; e < 4; ++e) { const int qi = rb * 16 + q * 4 + e; br[(size_t)(tq0 + qi) * DM + 768 + h * 64 + (cb0 + i) * 16 + r] = f2bf(oacc[i][e] / LSUM[qi]); }
    __syncthreads();
}

__device__ __forceinline__ void branch_phase(const Ctx& p, int l, LAS unsigned char* lds) {
    const int tid = get_tid(), lane = tid & 63, w = tid >> 6, r = lane & 15, q = lane >> 4;
    LAS bf16_t* As = (LAS bf16_t*)lds;
    const bf16_t* br = (const bf16_t*)(p.ws + WS_BR);
    const bf16_t* wb = (const bf16_t*)(p.ws + WS_W + (size_t)l * WL_STRIDE + WL_BR);
    const bf16_t* gates = (const bf16_t*)(p.ws + WS_GATES);
    bf16_t* merged = (bf16_t*)(p.ws + WS_MERGED);
    for (int tile = get_bid(); tile < 256; tile += get_nb()) {
        const int t0 = tile * 32;
#pragma unroll
        for (int i = 0; i < 8; ++i) { const int idx = i * 512 + tid, row = idx >> 7, c8 = (idx & 127) * 8;
            *(LAS u32x4*)(As + row * 1032 + c8) = *(const u32x4*)(br + (size_t)(t0 + row) * DM + c8); }
        __syncthreads();
#pragma unroll 1
        for (int ct = 0; ct < 8; ++ct) {
            const int d0 = w * 128 + ct * 16;
            f32x4 R[2] = {{0.f, 0.f, 0.f, 0.f}, {0.f, 0.f, 0.f, 0.f}};
            bf16x8 wf[8];
#pragma unroll
            for (int ks = 0; ks < 8; ++ks) wf[ks] = *(const bf16x8*)(wb + (size_t)(0 * 1024 + d0 + r) * 256 + ks * 32 + q * 8);
#pragma unroll
            for (int n = 0; n < 4; ++n) {
                bf16x8 wn[8];
                if (n < 3) {
#pragma unroll
                    for (int ks = 0; ks < 8; ++ks) wn[ks] = *(const bf16x8*)(wb + (size_t)((n + 1) * 1024 + d0 + r) * 256 + ks * 32 + q * 8);
                }
                u32x2 gw[2];
#pragma unroll
                for (int rt = 0; rt < 2; ++rt) gw[rt] = *(const u32x2*)(gates + (size_t)(t0 + rt * 16 + r) * NGATE + n * DM + d0 + q * 4);
                f32x4 U[2] = {{0.f, 0.f, 0.f, 0.f}, {0.f, 0.f, 0.f, 0.f}};
#pragma unroll
                for (int ks = 0; ks < 8; ++ks)
#pragma unroll
                    for (int rt = 0; rt < 2; ++rt) { const bf16x8 bfr = *(const LAS bf16x8*)(As + (rt * 16 + r) * 1032 + n * 256 + ks * 32 + q * 8);
                        U[rt] = __builtin_amdgcn_mfma_f32_16x16x32_bf16(wf[ks], bfr, U[rt], 0, 0, 0); }
#pragma unroll
                for (int rt = 0; rt < 2; ++rt) { R[rt][0] += bflo(gw[rt].x) * U[rt][0]; R[rt][1] += bfhi(gw[rt].x) * U[rt][1]; R[rt][2] += bflo(gw[rt].y) * U[rt][2]; R[rt][3] += bfhi(gw[rt].y) * U[rt][3]; }
                if (n < 3) {
#pragma unroll
                    for (int ks = 0; ks < 8; ++ks) wf[ks] = wn[ks];
                }
            }
#pragma unroll
            for (int rt = 0; rt < 2; ++rt) { u32x2 o; o.x = pk2(R[rt][0], R[rt][1]); o.y = pk2(R[rt][2], R[rt][3]);
                *(u32x2*)(merged + (size_t)(t0 + rt * 16 + r) * DM + d0 + q * 4) = o; }
        }
        __syncthreads();
    }
}

__device__ __forceinline__ void gate_sum_phase(const Ctx& p) {
    const int tid = get_tid();
    const bf16_t* gates = (const bf16_t*)(p.ws + WS_GATES);
    const bf16_t* up = (const bf16_t*)(p.ws + WS_PART);
    bf16_t* merged = (bf16_t*)(p.ws + WS_MERGED);
    const int NT = get_nb() * 512;
    for (int i = get_bid() * 512 + tid; i < T_ALL * 128; i += NT) {
        const int t = i >> 7, c8 = (i & 127) * 8;
        u32x4 g[4], u[4];
#pragma unroll
        for (int n = 0; n < 4; ++n) { g[n] = *(const u32x4*)(gates + (size_t)t * NGATE + n * DM + c8); u[n] = *(const u32x4*)(up + (size_t)t * NGATE + n * DM + c8); }
        float acc[8] = {0.f, 0.f, 0.f, 0.f, 0.f, 0.f, 0.f, 0.f};
#pragma unroll
        for (int n = 0; n < 4; ++n) { float gf[8], uf[8]; unpack8(g[n], gf); unpack8(u[n], uf);
#pragma unroll
            for (int e = 0; e < 8; ++e) acc[e] += gf[e] * uf[e]; }
        *(u32x4*)(merged + (size_t)t * DM + c8) = pack8(acc);
    }
}

__device__ __forceinline__ void na2_item(const Ctx& p, int l, int kind, int b, int h, int qt2, LAS unsigned char* lds) {
    const int tid = get_tid(), lane = tid & 63, w = tid >> 6, r = lane & 15, q = lane >> 4;
    LAS bf16_t* Qs = (LAS bf16_t*)lds;
    LAS bf16_t* Kb = Qs + 128 * 72;
    LAS bf16_t* Vb = Kb + 2 * 64 * 72;
    LAS bf16_t* Pw = Vb + 2 * 64 * 72 + w * (16 * 72);
    const bf16_t* proj = (const bf16_t*)(p.ws + WS_PROJ);
    const int tq0 = kind ? T_CTX + b * 1024 + qt2 * 128 : b * 256 + qt2 * 128;
    const int r0 = 2 * qt2;
    const int lo = kind ? min(max(r0 - 4, 0), 8) : 0, hi = kind ? min(max(r0 + 1 - 4, 0), 8) + 7 : 0;
    const int nloc = kind ? hi - lo + 1 : 0, nblk = nloc + 4;
    const int j = tid >> 3, d0 = (tid & 7) * 8;
#pragma unroll
    for (int i = 0; i < 2; ++i) { const int row = j + 64 * i; *(LAS u32x4*)(Qs + row * 72 + d0) = *(const u32x4*)(proj + (size_t)(tq0 + row) * NPROJ + C_NQ + h * 64 + d0); }
    auto loadkv = [&](int blk, u32x4& kreg, u32x4& vreg) {
        if (kind == 0 || blk < nloc) {
            const int tk = kind ? T_CTX + b * 1024 + (lo + blk) * 64 + j : b * 256 + blk * 64 + j;
            kreg = *(const u32x4*)(proj + (size_t)tk * NPROJ + C_NK + h * 64 + d0);
            vreg = *(const u32x4*)(proj + (size_t)tk * NPROJ + C_NV + h * 64 + d0);
        } else {
            const size_t off = ((size_t)((b * 4 + l) * 256 + (blk - nloc) * 64 + j) * 4 + h) * 64 + d0;
            const f32x4 k0 = *(const f32x4*)(PIN(I_CK) + off), k1 = *(const f32x4*)(PIN(I_CK) + off + 4);
            const f32x4 v0 = *(const f32x4*)(PIN(I_CV) + off), v1 = *(const f32x4*)(PIN(I_CV) + off + 4);
            kreg.x = pk2(k0[0], k0[1]); kreg.y = pk2(k0[2], k0[3]); kreg.z = pk2(k1[0], k1[1]); kreg.w = pk2(k1[2], k1[3]);
            vreg.x = pk2(v0[0], v0[1]); vreg.y = pk2(v0[2], v0[3]); vreg.z = pk2(v1[0], v1[1]); vreg.w = pk2(v1[2], v1[3]);
        }
    };
    u32x4 knext, vnext;
    loadkv(0, knext, vnext);
    f32x4 oacc[4];
#pragma unroll
    for (int dt = 0; dt < 4; ++dt) oacc[dt] = (f32x4){0.f, 0.f, 0.f, 0.f};
    float mrun[4] = {-1e30f, -1e30f, -1e30f, -1e30f}, lrun[4] = {0.f, 0.f, 0.f, 0.f};
    const float* rpb = PIN(I_RPB) + (size_t)(l * 4 + h) * 15 * 31;
    const int qrow = r0 + (w >> 2);
    const int rsq = min(max(qrow - 4, 0), 8);
    for (int blk = 0; blk < nblk; ++blk) {
        LAS bf16_t* Ks = Kb + (blk & 1) * (64 * 72); LAS bf16_t* VTs = Vb + (blk & 1) * (64 * 72);
        *(LAS u32x4*)(Ks + j * 72 + d0) = knext;
        { const unsigned vw[4] = {vnext.x, vnext.y, vnext.z, vnext.w};
#pragma unroll
            for (int e = 0; e < 4; ++e) { VTs[(d0 + 2 * e) * 72 + j] = (bf16_t)(vw[e] & 0xffffu); VTs[(d0 + 2 * e + 1) * 72 + j] = (bf16_t)(vw[e] >> 16); } }
        if (blk + 1 < nblk) loadkv(blk + 1, knext, vnext);
        __syncthreads();
        const bool local = kind && blk < nloc;
        const int kr = lo + blk;
        const bool rowok = !local || (kr >= rsq && kr < rsq + 8);
        f32x4 sc[4];
#pragma unroll
        for (int cb = 0; cb < 4; ++cb) { f32x4 a = {0.f, 0.f, 0.f, 0.f}; a = mma_k<2>(Qs, 72, w * 16, 0, Ks, 72, cb * 16, 0, a, lane);
#pragma unroll
            for (int e = 0; e < 4; ++e) { float sv = a[e] * 0.125f;
                if (local) { const int qc = (w & 3) * 16 + q * 4 + e, kc = cb * 16 + r, cs = min(max(qc - 8, 0), 48), cidx = min(max(kc - qc + 15, 0), 30);
                    sv = (rowok && kc >= cs && kc < cs + 16) ? sv + rpb[(kr - qrow + 7) * 31 + cidx] : -1e30f; }
                a[e] = sv; }
            sc[cb] = a; }
        float alpha[4];
#pragma unroll
        for (int e = 0; e < 4; ++e) {
            float bm = fmaxf(fmaxf(sc[0][e], sc[1][e]), fmaxf(sc[2][e], sc[3][e]));
            bm = fmaxf(bm, __shfl_xor(bm, 1)); bm = fmaxf(bm, __shfl_xor(bm, 2)); bm = fmaxf(bm, __shfl_xor(bm, 4)); bm = fmaxf(bm, __shfl_xor(bm, 8));
            const float mnew = fmaxf(mrun[e], bm); alpha[e] = __expf(mrun[e] - mnew); mrun[e] = mnew;
            float ps = 0.f;
#pragma unroll
            for (int cb = 0; cb < 4; ++cb) { const float sv = sc[cb][e]; const float pv = (sv > -1e29f) ? __expf(sv - mnew) : 0.f; sc[cb][e] = pv; ps += pv; }
            ps += __shfl_xor(ps, 1); ps += __shfl_xor(ps, 2); ps += __shfl_xor(ps, 4); ps += __shfl_xor(ps, 8);
            lrun[e] = lrun[e] * alpha[e] + ps;
        }
#pragma unroll
        for (int cb = 0; cb < 4; ++cb)
#pragma unroll
            for (int e = 0; e < 4; ++e) Pw[(q * 4 + e) * 72 + cb * 16 + r] = f2bf(sc[cb][e]);
#pragma unroll
        for (int dt = 0; dt < 4; ++dt)
#pragma unroll
            for (int e = 0; e < 4; ++e) oacc[dt][e] *= alpha[e];
        LDS_WAIT();
#pragma unroll
        for (int dt = 0; dt < 4; ++dt) oacc[dt] = mma_k<2>(Pw, 72, 0, 0, VTs, 72, dt * 16, 0, oacc[dt], lane);
        LDS_WAIT();
    }
    bf16_t* br = (bf16_t*)(p.ws + WS_BR);
#pragma unroll
    for (int dt = 0; dt < 4; ++dt)
#pragma unroll
        for (int e = 0; e < 4; ++e) br[(size_t)(tq0 + w * 16 + q * 4 + e) * DM + 768 + h * 64 + dt * 16 + r] = f2bf(oacc[dt][e] / lrun[e]);
    __syncthreads();
}

__device__ __forceinline__ void mixer_phase1(const Ctx& p, int l, LAS unsigned char* lds, int qoff) {
    const int tid = get_tid();
    volatile LAS int* slot = (volatile LAS int*)(lds + LDS_MAIN + 32);
    unsigned* ctr = (unsigned*)(p.ws + WS_CTR) + l * 64 + qoff;
    int it = get_bid();
    while (it < 704) {
        if (it < 32) { const int r = it; gla_state_item(p, l, 1, r >> 3, (r >> 1) & 3, r & 1, lds); }
        else if (it < 64) { const int r = it - 32; ret_state_item(p, l, 1, r >> 3, (r >> 1) & 3, r & 1, lds); }
        else if (it < 192) { const int r = it - 64; na2_item(p, l, 1, r >> 5, (r >> 3) & 3, r & 7, lds); }
        else if (it < 320) { const int r = it - 192;
            if (r < 64) { const int rr = r; s5_item(p, l, 1, rr >> 4, (rr >> 3) & 1, (rr >> 2) & 1, (rr & 3) * 4, lds); }
            else { const int rr = r - 64; s5_item(p, l, 0, rr >> 2, (rr >> 1) & 1, rr & 1, 0, lds); }
            __syncthreads(); }
        else if (it < 448) { const int r = it - 320; gla_state_item(p, l, 0, r >> 3, (r >> 1) & 3, r & 1, lds); }
        else if (it < 576) { const int r = it - 448; na2_item(p, l, 0, r >> 3, (r >> 1) & 3, r & 1, lds); }
        else { const int r = it - 576; ret_state_item(p, l, 0, r >> 3, (r >> 1) & 3, r & 1, lds); }
        if (tid == 0) *slot = (int)atomicAdd(ctr, 1u) + get_nb();
        __syncthreads();
        it = *slot;
        __syncthreads();
    }
}
__device__ __forceinline__ void mixer_phase2(const Ctx& p, int l, LAS unsigned char* lds, int qoff) {
    const int tid = get_tid();
    volatile LAS int* slot = (volatile LAS int*)(lds + LDS_MAIN + 32);
    unsigned* ctr = (unsigned*)(p.ws + WS_CTR) + l * 64 + 32 + qoff;
    int it = get_bid();
    while (it < 1152) {
        if (it < 128) s5_glu_item(p, l, 127 - it, lds);
        else {
            const int r = (it - 128) & 511; const bool gla = it >= 640;
            int path, b, h, c;
            if (r < 256) { path = 1; b = r >> 6; h = (r >> 4) & 3; c = r & 15; } else { const int rr = r - 256; path = 0; b = rr >> 4; h = (rr >> 2) & 3; c = rr & 3; }
            if (gla) gla_out_item(p, l, path, b, h, c, lds); else ret_out_item(p, l, path, b, h, c, lds);
        }
        if (tid == 0) *slot = (int)atomicAdd(ctr, 1u) + get_nb();
        __syncthreads();
        it = *slot;
        __syncthreads();
    }
}

__global__ void __launch_bounds__(512) fwd_megakernel(Params p) {
    extern __shared__ __attribute__((aligned(16))) unsigned char smem_raw[];
    LAS unsigned char* lds = (LAS unsigned char*)smem_raw;
    cg::grid_group grid = cg::this_grid();
    const int G = get_nb(), c = get_bid();
    const int ph_lo = p.ph_lo, ph_hi = p.ph_hi;
    volatile LAS unsigned* bst = (volatile LAS unsigned*)(lds + LDS_MAIN);
    if (threadIdx.x < 16) bst[threadIdx.x] = 0u;
    __syncthreads();
    if (threadIdx.x == 0) (void)xb_add(&((unsigned*)(p.ws + WS_BAR))[XB_XCNT(xb_xcc_id())], 1u);
    if (ph_hi > 1000) grid.sync();
#define GRID_SYNC() xcd_barrier((unsigned*)(p.ws + WS_BAR), bst)
#ifndef NO_P0
    if (ph_lo == 0) phase0(p, lds);
#if defined(PROBE_DUP) && PROBE_DUP == 100
    GRID_SYNC(); if (ph_lo == 0) phase0(p, lds);
#endif
#endif
    for (int ph = (ph_lo == 0 ? 1 : ph_lo); ph < ph_hi; ++ph) {
        if (ph > ph_lo) GRID_SYNC();
        Ctx q;
        { GAS unsigned char* ws = (GAS unsigned char*)p.ws; GAS float* out = (GAS float*)p.out; asm volatile("" : "+s"(ws), "+s"(out)); q.ws = (unsigned char*)ws; q.out = (float*)out; q.in = (const GAS float* const*)(q.ws + WS_TAB); }
        if (ph == 41) { row_phase(q, 4, 0); continue; }
        const int l = (ph - 1) / 10, k = (ph - 1) % 10;
#if !(defined(PROBE_DUP) && PROBE_DUP < 100)
#define QOFF 0
#endif
#if defined(PROBE_DUP) && PROBE_DUP < 100
#define QOFF (rep * 8)
        for (int rep = 0; rep < ((k == PROBE_DUP) ? 2 : 1); ++rep) {
        if (rep) GRID_SYNC();
#endif
#if defined(PROBE_DUP) && PROBE_DUP == 101
        GRID_SYNC();
#endif
        unsigned char* wl = q.ws + WS_W + (size_t)l * WL_STRIDE;
        if (k == 0) { row_phase(q, l, 0); continue; }
#ifndef NO_M1
        if (k == 2) { mixer_phase1(q, l, lds, QOFF); continue; }
#endif
#ifndef NO_M2
        if (k == 3) { mixer_phase2(q, l, lds, QOFF); continue; }
#endif
        if (k == 7) { row_phase(q, l, 1); continue; }
        if (k == 5) { gate_sum_phase(q); continue; }
#ifndef NO_GEMM
        pg8::Sched S; pg8::Gemm g; pg8::Epi E;
        E.l = l; E.bias = ((const float*)q.in[I_BMG]) + (size_t)l * 4096; E.nak = q.out + O_NAK; E.nav = q.out + O_NAV;
        E.g16 = (bf16_t*)(q.ws + WS_GATES); E.f32 = (float*)(q.ws + WS_PART);
        if (k == 1) { S.init(32, 28, G, c, 0, 0u); g = pg8::Gemm{(const bf16_t*)(q.ws + WS_H), (const bf16_t*)(wl + WL_CAT), 1024, 1024, 1024}; E.mode = 0; E.o16 = (bf16_t*)(q.ws + WS_PROJ); }
        else if (k == 4) { S.init(32, 16, G, c, 3, 0u); g = pg8::Gemm{(const bf16_t*)(q.ws + WS_BR), (const bf16_t*)(wl + WL_BR), 256, 1024, 256}; E.mode = 4; E.o16 = (bf16_t*)(q.ws + WS_PART); }
        else if (k == 6) { S.init(32, 8, G, c, 1, 512u * 2u); g = pg8::Gemm{(const bf16_t*)(q.ws + WS_MERGED), (const bf16_t*)(wl + WL_OUT), 512, 1024, 1024}; E.mode = 2; E.o16 = nullptr; }
        else if (k == 8) { S.init(32, 16, G, c, 0, 0u); g = pg8::Gemm{(const bf16_t*)(q.ws + WS_H), (const bf16_t*)(wl + WL_M1), 1024, 1024, 1024}; E.mode = 3; E.o16 = (bf16_t*)(q.ws + WS_GATES); }
        else { S.init(32, 8, G, c, 1, 2048u * 2u); g = pg8::Gemm{(const bf16_t*)(q.ws + WS_GATES), (const bf16_t*)(wl + WL_M2), 2048, 4096, 4096}; E.mode = 2; E.o16 = nullptr; }
        pg8::gemm_phase(lds, g, S, E);
#endif
#if defined(PROBE_DUP) && PROBE_DUP < 100
        }
#endif
    }
}

extern "C" void kernel_launch(void* const* d_in, const int* in_sizes, int n_in, void* d_out, int out_size, void* d_ws, size_t ws_size, hipStream_t stream) {
    static int grid_blocks = 0;
    if (grid_blocks == 0) {
        if (n_in != N_IN || ws_size < WS_END) { fprintf(stderr, "kernel_launch: unexpected inputs (n_in %d, ws %zu, need %zu)\n", n_in, ws_size, (size_t)WS_END); grid_blocks = -1; return; }
        int dev = 0, cus = 0, per_cu = 0;
        hipGetDevice(&dev);
        hipDeviceGetAttribute(&cus, hipDeviceAttributeMultiprocessorCount, dev);
        if (hipFuncSetAttribute((const void*)fwd_megakernel, hipFuncAttributeMaxDynamicSharedMemorySize, LDS_BYTES) != hipSuccess) { fprintf(stderr, "kernel_launch: hipFuncSetAttribute failed\n"); (void)hipGetLastError(); }
        if (hipOccupancyMaxActiveBlocksPerMultiprocessor(&per_cu, (const void*)fwd_megakernel, 512, LDS_BYTES) != hipSuccess || per_cu < 1) { fprintf(stderr, "kernel_launch: occupancy query gave %d\n", per_cu); (void)hipGetLastError(); per_cu = 1; }
        grid_blocks = cus;
    }
    if (grid_blocks < 0) return;
    if (hipMemsetAsync((unsigned char*)d_ws + WS_BAR, 0, 16384 + 4096, stream) != hipSuccess) { fprintf(stderr, "kernel_launch: memset failed\n"); return; }
    Params p{};
    for (int i = 0; i < N_IN; ++i) p.in[i] = (const float*)d_in[i];
    p.out = (float*)d_out; p.ws = (unsigned char*)d_ws; p.ph_lo = 0; p.ph_hi = 42;
    void* args[] = {&p};
    hipError_t e = hipLaunchCooperativeKernel((const void*)fwd_megakernel, dim3(grid_blocks), dim3(512), args, LDS_BYTES, stream);
    if (e != hipSuccess) fprintf(stderr, "cooperative launch failed: %s (grid %d)\n", hipGetErrorString(e), grid_blocks);
}
```

```cpp
#include <hip/hip_runtime.h>
#include <hip/hip_cooperative_groups.h>
#include <cstdio>
#include <cstdint>
namespace cg = cooperative_groups;

#define LAS __attribute__((address_space(3)))
#define GAS __attribute__((address_space(1)))
typedef unsigned short bf16_t;
typedef short bf16x8 __attribute__((ext_vector_type(8)));
typedef float f32x4 __attribute__((ext_vector_type(4)));
typedef unsigned u32x4 __attribute__((ext_vector_type(4)));
typedef unsigned u32x2 __attribute__((ext_vector_type(2)));

constexpr int T_ALL = 8192, T_CTX = 4096, DM = 1024, NPROJ = 3072, NGATE = 4096, DFF = 4096;
constexpr int C_RQ = 0, C_RK = 256, C_RV = 512, C_RG = 768, C_SU = 1024, C_GQ = 1280, C_GK = 1408, C_GV = 1536, C_GG = 1792,
              C_NQ = 2048, C_NK = 2304, C_NV = 2560, C_GLR = 2816;
constexpr float EPS = 1e-6f;
enum { I_XP = 0, I_XS, I_C, I_CK, I_CV, I_SRET, I_SS5, I_SGLA, I_CCTX, I_WADA, I_BADA, I_GN, I_WIN, I_RLD, I_RGN, I_S5LR, I_S5LI, I_S5DT,
       I_S5BR, I_S5BI, I_S5CR, I_S5CI, I_S5D, I_S5WG, I_S5BG, I_GWG, I_GBG, I_GGN, I_RPB, I_WBR, I_WMG, I_BMG, I_WOUT, I_W1, I_W2, N_IN };
constexpr size_t O_X = 0, O_NAK = 8388608, O_NAV = 12582912, O_RET = 16777216, O_S5 = 18874368, O_GLA = 19136512;
constexpr size_t WL_CAT = 0, WL_BR = 14680064, WL_OUT = WL_BR + 2097152, WL_M1 = WL_OUT + 2097152, WL_M2 = WL_M1 + 8388608, WL_GLU = WL_M2 + 8388608,
                 WL_STRIDE = WL_GLU + 262144;
constexpr size_t WS_W = 0, WS_MOD = WS_W + 4 * WL_STRIDE, WS_H = WS_MOD + 491520, WS_PROJ = WS_H + 16777216, WS_GATES = WS_PROJ + 50331648,
                 WS_BR = WS_GATES + 67108864, WS_MERGED = WS_BR + 16777216, WS_PART = WS_MERGED + 16777216, WS_TAB = WS_PART + 67108864, WS_BAR = WS_TAB + 4096, WS_CTR = WS_BAR + 16384, WS_END = WS_CTR + 4096;
constexpr size_t WS_S5Y = WS_PART, WS_RETS = WS_PART + 16777216, WS_GLAS = WS_RETS + 8388608, WS_S5E = WS_GLAS + 4194304;
constexpr int LDS_MAIN = 131072, LDS_BYTES = LDS_MAIN + 64;

struct Params { const float* in[N_IN]; float* out; unsigned char* ws; int ph_lo, ph_hi; };
struct Ctx { const GAS float* const* in; float* out; unsigned char* ws; };
#define PIN(i) ((const float*)(p.in[i]))

typedef float f32x2_t __attribute__((ext_vector_type(2)));
typedef __bf16 bf16x2_t __attribute__((ext_vector_type(2)));
__device__ __forceinline__ unsigned pk2(float lo, float hi) { const f32x2_t v = {lo, hi}; const bf16x2_t h = __builtin_convertvector(v, bf16x2_t); return __builtin_bit_cast(unsigned, h); }
__device__ __forceinline__ bf16_t f2bf(float f) { return (bf16_t)(pk2(f, 0.f) & 0xffffu); }
__device__ __forceinline__ float bflo(unsigned u) { return __uint_as_float(u << 16); }
__device__ __forceinline__ float bfhi(unsigned u) { return __uint_as_float(u & 0xffff0000u); }
__device__ __forceinline__ float bf2f(bf16_t b) { return __uint_as_float(((unsigned)b) << 16); }
__device__ __forceinline__ void unpack8(u32x4 v, float (&f)[8]) { f[0] = bflo(v.x); f[1] = bfhi(v.x); f[2] = bflo(v.y); f[3] = bfhi(v.y); f[4] = bflo(v.z); f[5] = bfhi(v.z); f[6] = bflo(v.w); f[7] = bfhi(v.w); }
__device__ __forceinline__ u32x4 pack8(const float (&f)[8]) { u32x4 o; o.x = pk2(f[0], f[1]); o.y = pk2(f[2], f[3]); o.z = pk2(f[4], f[5]); o.w = pk2(f[6], f[7]); return o; }
__device__ __forceinline__ float sigmoidf_(float x) { return __builtin_amdgcn_rcpf(1.f + __expf(-x)); }
__device__ __forceinline__ float siluf_(float x) { return x * sigmoidf_(x); }
__device__ __forceinline__ float wave_sum(float v) {
#pragma unroll
    for (int o = 1; o < 64; o <<= 1) v += __shfl_xor(v, o);
    return v;
}
__device__ __forceinline__ int get_tid() { int t = threadIdx.x; asm volatile("" : "+v"(t)); return t; }
__device__ __forceinline__ int get_bid() { int b = blockIdx.x; asm volatile("" : "+s"(b)); return b; }
__device__ __forceinline__ int get_nb() { int b = gridDim.x; asm volatile("" : "+s"(b)); return b; }
#define LDS_WAIT() asm volatile("s_waitcnt lgkmcnt(0)" ::: "memory")

template <int KSTEPS>
__device__ __forceinline__ f32x4 mma_k(const LAS bf16_t* A, int lda, int arow0, int ak0, const LAS bf16_t* B, int ldb, int brow0, int bk0, f32x4 acc, int lane) {
    const int r = lane & 15, q = lane >> 4;
    const LAS bf16_t* ap = A + (arow0 + r) * lda + ak0 + q * 8;
    const LAS bf16_t* bp = B + (brow0 + r) * ldb + bk0 + q * 8;
#pragma unroll
    for (int kk = 0; kk < KSTEPS; ++kk) {
        const bf16x8 a = *(const LAS bf16x8*)(ap + kk * 32), b = *(const LAS bf16x8*)(bp + kk * 32);
        acc = __builtin_amdgcn_mfma_f32_16x16x32_bf16(a, b, acc, 0, 0, 0);
    }
    return acc;
}


#define XB_TMO      128
#define XB_XCNT(j)  (256  + 64 * (j))
#define XB_XSUB(j)  (1280 + 64 * (j))
#define XB_XGEN(j)  (2304 + 64 * (j))
#define XB_TOP      3328
#define XB_TOPGEN   3392
#define XCD_BAR_WORDS 3456
#define XB_SPIN_CAP (1u << 20)
__device__ __forceinline__ unsigned xb_ld(unsigned* p)              { return __hip_atomic_load(p, __ATOMIC_RELAXED, __HIP_MEMORY_SCOPE_AGENT); }
__device__ __forceinline__ unsigned xb_add(unsigned* p, unsigned v) { return __hip_atomic_fetch_add(p, v, __ATOMIC_RELAXED, __HIP_MEMORY_SCOPE_AGENT); }
__device__ __forceinline__ unsigned xb_xcc_id() { return (unsigned)__builtin_amdgcn_s_getreg((3 << 11) | 20) & 0xFu; }
#define XB_SPIN(cond, bar) do { unsigned _sp = 0; while (cond) { __builtin_amdgcn_s_sleep(1); \
    if ((++_sp & 255u) == 0u) { if (xb_ld(&(bar)[XB_TMO])) break; if (_sp > XB_SPIN_CAP) { atomicAdd(&(bar)[XB_TMO], 1u); break; } } } } while (0)
__device__ __forceinline__ void xcd_barrier_complete(unsigned* bar, unsigned x, unsigned& nloc, unsigned& nx) {
    const unsigned G = gridDim.x;
    unsigned sum, cnt, mine, sp = 0u;
    for (;;) {
        sum = 0u; cnt = 0u; mine = 0u;
#pragma unroll
        for (unsigned j = 0; j < 16; ++j) { const unsigned c = xb_ld(&bar[XB_XCNT(j)]); sum += c; cnt += (c > 0u) ? 1u : 0u; mine = (j == x) ? c : mine; }
        if (sum == G) break;
        __builtin_amdgcn_s_sleep(1);
        if ((++sp & 255u) == 0u) { if (xb_ld(&bar[XB_TMO])) break; if (sp > XB_SPIN_CAP) { atomicAdd(&bar[XB_TMO], 1u); break; } }
    }
    nloc = mine > 0u ? mine : 1u; nx = cnt > 0u ? cnt : 1u;
}
__device__ __forceinline__ void xcd_barrier(unsigned* bar, volatile LAS unsigned* st) {
    asm volatile("s_waitcnt vmcnt(0)" ::: "memory");
    __syncthreads();
    if (threadIdx.x == 0) {
        __builtin_amdgcn_s_waitcnt(0);
        const unsigned x = xb_xcc_id();
        unsigned nloc = st[0], nx = st[1];
        if (nloc == 0u) { xcd_barrier_complete(bar, x, nloc, nx); st[0] = nloc; st[1] = nx; }
        const unsigned old = xb_add(&bar[XB_XSUB(x)], 1u);
        const unsigned gen = old / nloc;
        if (old + 1u == (gen + 1u) * nloc) {
            __builtin_amdgcn_fence(__ATOMIC_RELEASE, "agent");
            asm volatile("s_waitcnt vmcnt(0)" ::: "memory");
            const unsigned og = xb_add(&bar[XB_TOP], 1u);
            const unsigned tg = og / nx;
            if (og + 1u == (tg + 1u) * nx) xb_add(&bar[XB_TOPGEN], 1u);
            else XB_SPIN(xb_ld(&bar[XB_TOPGEN]) == tg, bar);
            __builtin_amdgcn_fence(__ATOMIC_ACQUIRE, "agent");
            xb_add(&bar[XB_XGEN(x)], 1u);
            asm volatile("s_waitcnt vmcnt(0)" ::: "memory");
        } else {
            XB_SPIN(xb_ld(&bar[XB_XGEN(x)]) == gen, bar);
            __builtin_amdgcn_fence(__ATOMIC_ACQUIRE, "agent");
            asm volatile("s_waitcnt vmcnt(0)" ::: "memory");
        }
    }
    __syncthreads();
}

namespace pg8 {
constexpr int BM = 256, BK = 64, HALF = 128, HTB = HALF * BK * 2, NXCD = 8, WGM = 8;
__device__ __forceinline__ int lds_byte(int r, int c) { const int st = (r >> 4) * 2 + (c >> 5), rr = r & 15, cc = c & 31, ob = rr * 64 + cc * 2; return st * 1024 + (ob ^ (((ob >> 9) & 1) << 5)); }
__device__ __forceinline__ void stage_rc(int b, int& R, int& C) { const int st = b / 1024, sb = b % 1024, swz = sb ^ (((sb >> 9) & 1) << 5); R = (st >> 1) * 16 + swz / 64; C = (st & 1) * 32 + (swz % 64) / 2; }
__device__ __forceinline__ int perm32(int rho) { const int n = rho >> 4, i = rho & 15; return 8 * (i >> 2) + 4 * n + (i & 3); }
struct Unit { int pm, pn, tag; };
struct Gemm { const bf16_t* A; const bf16_t* Bt; int K, lda, ldb; };
struct Sched {
    int nM, nN, nwg, G, c, mode; unsigned amul, bmul;
    __device__ __forceinline__ void init(int nM_, int nN_, int G_, int c_, int mode_, unsigned koff_) { nM = nM_; nN = nN_; nwg = nM * nN; G = G_; c = c_; mode = mode_; amul = (mode_ == 2 || mode_ == 3) ? 512u : koff_; bmul = (mode_ == 2) ? 524288u : (mode_ == 3 ? 0u : koff_); }
    __device__ __forceinline__ bool next(int i, Unit& u) const {
        if (mode == 2) {
            if (c >= 128 || i >= 4) return false;
            u.pm = c >> 2; u.pn = c & 3; u.tag = i; return true;
        }
        const long L = (long)i * G + c; if (L >= nwg) return false;
        int wgid = (int)L; { const int q = nwg / NXCD, r = nwg % NXCD, xcd = wgid % NXCD, off = wgid / NXCD; wgid = (xcd < r ? xcd * (q + 1) : r * (q + 1) + (xcd - r) * q) + off; }
        const int nig = WGM * nN, gid = wgid / nig, fm = gid * WGM, gsz = (nM - fm) < WGM ? (nM - fm) : WGM;
        u.pm = fm + ((wgid % nig) % gsz); const int pnx = (wgid % nig) / gsz;
        if (mode == 1) { u.pn = pnx & 3; u.tag = pnx >> 2; }
        else if (mode == 3) { u.pn = pnx; u.tag = pnx >> 2; }
        else { u.pn = pnx; u.tag = 0; }
        return true;
    }
};

template <class Epi>
__device__ __forceinline__ void gemm_phase(LAS unsigned char* lds, const Gemm g, const Sched& S, const Epi& E) {
    const int tid = get_tid(), wid = __builtin_amdgcn_readfirstlane(tid >> 6), lane = tid & 63, wr = wid >> 2, wc = wid & 3, fr = lane & 15, fq = lane >> 4;
    const int K = g.K, nt = K / BK;
    unsigned voffA[2], voffB[2];
#pragma unroll
    for (int i = 0; i < 2; ++i) { int R, C; stage_rc(tid * 16 + i * 8192, R, C); const int Rb = Epi::PERM ? ((R & ~31) + perm32(R & 31)) : R;
        voffA[i] = (unsigned)(R * g.lda + C) * 2u; voffB[i] = (unsigned)(Rb * g.ldb + C) * 2u; }
    const size_t kstep = (size_t)(BK * 2);
    const size_t hstepA = (size_t)HALF * g.lda * 2, hstepB = (size_t)HALF * g.ldb * 2;
    const size_t tstepA = 2 * hstepA, tstepB = 2 * hstepB;
    const unsigned ldsw = (unsigned)wid * 1024u;
    const int aoff = lds_byte(wr * 64 + fr, fq * 8), boff = lds_byte(wc * 32 + fr, fq * 8);
#define PG8_SA(b, h) (((b) * 2 + (h)) * HTB)
#define PG8_SB(b, h) ((4 + (b) * 2 + (h)) * HTB)
#define PG8_STAGE(bufoff, gbase, voff) do { _Pragma("unroll") for (int _i = 0; _i < 2; ++_i) \
        __builtin_amdgcn_global_load_lds((const unsigned*)((const char*)(gbase) + (voff)[_i]), (LAS unsigned*)(lds + (bufoff) + ldsw + _i * 8192), 16, 0, 0); } while (0)
#define PG8_LDA(dst, b, h) do { _Pragma("unroll") for (int m = 0; m < 4; ++m) _Pragma("unroll") for (int k = 0; k < 2; ++k) dst[m][k] = *(const LAS bf16x8*)(lds + PG8_SA(b, h) + aoff + m * 2048 + k * 1024); } while (0)
#define PG8_LDB(dst, b, h) do { _Pragma("unroll") for (int n = 0; n < 2; ++n) _Pragma("unroll") for (int k = 0; k < 2; ++k) dst[n][k] = *(const LAS bf16x8*)(lds + PG8_SB(b, h) + boff + n * 2048 + k * 1024); } while (0)
#define PG8_MMA(ai, bj, At, Bt) do { __builtin_amdgcn_s_setprio(1); _Pragma("unroll") for (int m = 0; m < 4; ++m) _Pragma("unroll") for (int n = 0; n < 2; ++n) _Pragma("unroll") for (int k = 0; k < 2; ++k) \
        acc[ai][bj][m][n] = __builtin_amdgcn_mfma_f32_16x16x32_bf16(Bt[n][k], At[m][k], acc[ai][bj][m][n], 0, 0, 0); __builtin_amdgcn_s_setprio(0); } while (0)
#define PG8_WAIT_V(n) asm volatile("s_waitcnt vmcnt(" #n ")" ::: "memory")
#define PG8_WAIT_L(n) asm volatile("s_waitcnt lgkmcnt(" #n ")" ::: "memory")
#define PG8_BAR __builtin_amdgcn_s_barrier()
#define PG8_SCHED __builtin_amdgcn_sched_barrier(0)
    Unit cur, nxt; int ui = 0;
    if (!S.next(0, cur)) return;
    f32x4 acc[2][2][4][2];
#pragma unroll
    for (int a = 0; a < 2; ++a)
#pragma unroll
        for (int b = 0; b < 2; ++b)
#pragma unroll
            for (int m = 0; m < 4; ++m)
#pragma unroll
                for (int n = 0; n < 2; ++n) acc[a][b][m][n] = (f32x4){0.f, 0.f, 0.f, 0.f};
    bf16x8 At[4][2], B0[2][2], B1[2][2];
    const char* cA = (const char*)g.A + (size_t)cur.pm * tstepA + (size_t)cur.tag * S.amul; const char* cB = (const char*)g.Bt + (size_t)cur.pn * tstepB + (size_t)cur.tag * S.bmul;
    PG8_STAGE(PG8_SB(0, 0), cB, voffB); PG8_STAGE(PG8_SB(0, 1), cB + hstepB, voffB); PG8_STAGE(PG8_SA(0, 0), cA, voffA); PG8_STAGE(PG8_SA(0, 1), cA + hstepA, voffA);
    if (wr == 1) PG8_BAR;
    PG8_WAIT_V(2); PG8_BAR;
    PG8_STAGE(PG8_SB(1, 0), cB + kstep, voffB); PG8_STAGE(PG8_SA(1, 0), cA + kstep, voffA); PG8_STAGE(PG8_SB(1, 1), cB + hstepB + kstep, voffB);
    PG8_WAIT_V(6); PG8_BAR;
    for (;;) {
        const bool has_next = S.next(ui + 1, nxt);
        const char* nA = has_next ? (const char*)g.A + (size_t)nxt.pm * tstepA + (size_t)nxt.tag * S.amul : cA; const char* nB = has_next ? (const char*)g.Bt + (size_t)nxt.pn * tstepB + (size_t)nxt.tag * S.bmul : cB;
        for (int t = 0; t < nt; t += 2) {
            const bool last = (t == nt - 2);
            const char* a1 = cA + (size_t)(t + 1) * kstep;
            const char* a2 = last ? nA : cA + (size_t)(t + 2) * kstep; const char* b2 = last ? nB : cB + (size_t)(t + 2) * kstep;
            const char* a3 = a2 + kstep; const char* b3 = b2 + kstep;
            PG8_LDB(B0, 0, 0); PG8_LDB(B1, 0, 1); PG8_SCHED; PG8_LDA(At, 0, 0); PG8_STAGE(PG8_SA(1, 1), a1 + hstepA, voffA);
            PG8_WAIT_V(8); PG8_WAIT_L(0); PG8_BAR; PG8_MMA(0, 0, At, B0); PG8_MMA(0, 1, At, B1); PG8_BAR; PG8_SCHED;
            PG8_LDA(At, 0, 1); PG8_STAGE(PG8_SB(0, 0), b2, voffB); PG8_STAGE(PG8_SB(0, 1), b2 + hstepB, voffB); PG8_STAGE(PG8_SA(0, 0), a2, voffA);
            PG8_WAIT_V(8); PG8_WAIT_L(0); PG8_BAR; PG8_MMA(1, 0, At, B0); PG8_MMA(1, 1, At, B1); PG8_BAR; PG8_SCHED;
            PG8_LDB(B0, 1, 0); PG8_LDB(B1, 1, 1); PG8_SCHED; PG8_LDA(At, 1, 0); PG8_STAGE(PG8_SA(0, 1), a2 + hstepA, voffA);
            PG8_WAIT_V(8); PG8_WAIT_L(0); PG8_BAR; PG8_MMA(0, 0, At, B0); PG8_MMA(0, 1, At, B1); PG8_BAR; PG8_SCHED;
            PG8_LDA(At, 1, 1); PG8_STAGE(PG8_SB(1, 0), b3, voffB); PG8_STAGE(PG8_SB(1, 1), b3 + hstepB, voffB); PG8_STAGE(PG8_SA(1, 0), a3, voffA);
            PG8_WAIT_V(8); PG8_WAIT_L(0); PG8_BAR; PG8_MMA(1, 0, At, B0); PG8_MMA(1, 1, At, B1); PG8_BAR; PG8_SCHED;
        }
        if (wr == 0) PG8_BAR;
        E(acc, cur, wr, wc, fr, fq);
        if (!has_next) break;
#pragma unroll
        for (int a = 0; a < 2; ++a)
#pragma unroll
            for (int b = 0; b < 2; ++b)
#pragma unroll
                for (int m = 0; m < 4; ++m)
#pragma unroll
                    for (int n = 0; n < 2; ++n) acc[a][b][m][n] = (f32x4){0.f, 0.f, 0.f, 0.f};
        cur = nxt; cA = nA; cB = nB; ++ui;
        if (wr == 1) PG8_BAR;
    }
    PG8_WAIT_V(0);
    PG8_BAR;
#undef PG8_SA
#undef PG8_SB
#undef PG8_STAGE
#undef PG8_LDA
#undef PG8_LDB
#undef PG8_MMA
#undef PG8_WAIT_V
#undef PG8_WAIT_L
#undef PG8_BAR
#undef PG8_SCHED
}

struct Epi {
    static constexpr bool PERM = true;
    int mode, l; bf16_t* o16; bf16_t* g16; float* f32; const float* bias; float* nak; float* nav;
    __device__ __forceinline__ void operator()(const f32x4 (&acc)[2][2][4][2], const Unit& u, int wr, int wc, int fr, int fq) const {
        const int row0 = u.pm * BM + wr * 64 + fr, colt = wc * 32 + 8 * fq;
        const bool gate_tile = (mode == 0) && (u.pn >= 12);
        f32x4 bv[2][2];
#pragma unroll
        for (int bj = 0; bj < 2; ++bj)
#pragma unroll
            for (int n = 0; n < 2; ++n) bv[bj][n] = gate_tile ? *(const f32x4*)(bias + (u.pn - 12) * BM + colt + bj * HALF + 4 * n) : (f32x4){0.f, 0.f, 0.f, 0.f};
        const bool wna = (mode == 0) && (u.pn == 9 || u.pn == 10) && u.pm < 16;
        float* nbase = nak + ((u.pn == 9) ? (ptrdiff_t)0 : (nav - nak));
#pragma unroll
        for (int ai = 0; ai < 2; ++ai)
#pragma unroll
            for (int m = 0; m < 4; ++m) { const int row = row0 + ai * HALF + m * 16;
#pragma unroll
                for (int bj = 0; bj < 2; ++bj) {
                    f32x4 v0 = acc[ai][bj][m][0], v1 = acc[ai][bj][m][1];
                    const int ct = colt + bj * HALF;
                    if (mode == 2) { bf16_t* d = (bf16_t*)f32 + (size_t)u.tag * ((size_t)T_ALL * DM) + (size_t)row * DM + u.pn * BM + ct;
                        u32x4 w; w.x = pk2(v0[0], v0[1]); w.y = pk2(v0[2], v0[3]); w.z = pk2(v1[0], v1[1]); w.w = pk2(v1[2], v1[3]); *(u32x4*)d = w; continue; }
                    size_t oidx;
                    if (mode == 0) {
                        if (gate_tile) { v0 += bv[bj][0]; v1 += bv[bj][1];
#pragma unroll
                            for (int j = 0; j < 4; ++j) { v0[j] = sigmoidf_(v0[j]); v1[j] = sigmoidf_(v1[j]); }
                            oidx = (size_t)row * NGATE + (u.pn - 12) * BM + ct;
                        } else {
                            oidx = (size_t)row * NPROJ + u.pn * BM + ct;
                            if (wna) { float* d = nbase + ((size_t)((u.pm * 4 + l) * 256 + (row & 255)) * 256 + ct); *(f32x4*)d = v0; *(f32x4*)(d + 4) = v1; }
                        }
                    } else {
                        if (mode == 3) {
#pragma unroll
                        for (int j = 0; j < 4; ++j) { const float a = fmaxf(v0[j], 0.f), b = fmaxf(v1[j], 0.f); v0[j] = a * a; v1[j] = b * b; } }
                        oidx = (size_t)row * DFF + u.pn * BM + ct;
                    }
                    u32x4 w; w.x = pk2(v0[0], v0[1]); w.y = pk2(v0[2], v0[3]); w.z = pk2(v1[0], v1[1]); w.w = pk2(v1[2], v1[3]);
                    const ptrdiff_t gdelta = g16 - o16;
                    *(u32x4*)(o16 + (oidx + (gate_tile ? gdelta : (ptrdiff_t)0))) = w;
                }
                asm volatile("" ::: "memory"); }
    }
};
}

__device__ __forceinline__ void transpose_item(const float* W, int N, bf16_t* WT, int ldk, int dstrow0, int k0, int n0, LAS float* scr, int lane) {
#pragma unroll 8
    for (int i = 0; i < 32; ++i) { const int kk = 2 * i + (lane >> 5); scr[kk * 33 + (lane & 31)] = W[(size_t)(k0 + kk) * N + n0 + (lane & 31)]; }
    LDS_WAIT();
    const int c = lane & 7;
#pragma unroll
    for (int j = 0; j < 4; ++j) { const int n = (lane >> 3) + 8 * j; const LAS float* s = scr + (8 * c) * 33 + n;
        u32x4 o; o.x = pk2(s[0 * 33], s[1 * 33]); o.y = pk2(s[2 * 33], s[3 * 33]); o.z = pk2(s[4 * 33], s[5 * 33]); o.w = pk2(s[6 * 33], s[7 * 33]);
        *(u32x4*)(WT + (size_t)(dstrow0 + n) * ldk + k0 + 8 * c) = o; }
    LDS_WAIT();
}

__device__ __forceinline__ void phase0(const Params& p, LAS unsigned char* lds) {
    const int tid = get_tid(), lane = tid & 63, wave = tid >> 6;
    const int G = get_nb();
    if (get_bid() == 0 && tid < N_IN) ((const float**)(p.ws + WS_TAB))[tid] = p.in[tid];
    {
        LAS float* svec = (LAS float*)lds;
        LAS float* red = (LAS float*)(lds + 20480);
        bool have = false;
        for (int it = get_bid(); it < 384; it += G) {
            if (!have) {
                for (int i = tid; i < 5 * 1024; i += 512) { const int j = i >> 10, k = i & 1023; const float v = (j == 0) ? PIN(I_CCTX)[k] : PIN(I_C)[(j - 1) * 1024 + k]; svec[i] = siluf_(v); }
                __syncthreads(); have = true;
            }
            const int l = it / 96, cch = it % 96, cq = tid & 15, ks = tid >> 4, col = cch * 64 + cq * 4;
            f32x4 a0 = {0, 0, 0, 0}, a1 = a0, a2 = a0, a3 = a0, a4 = a0;
            const float* wp = PIN(I_WADA) + ((size_t)l * 1024 + ks * 32) * 6144 + col;
#pragma unroll 4
            for (int k = 0; k < 32; ++k) { const f32x4 w = *(const f32x4*)(wp + (size_t)k * 6144); const int kk = ks * 32 + k;
                a0 += svec[kk] * w; a1 += svec[1024 + kk] * w; a2 += svec[2048 + kk] * w; a3 += svec[3072 + kk] * w; a4 += svec[4096 + kk] * w; }
            LAS float* rp = red + ks * 320 + cq * 4;
#pragma unroll
            for (int e = 0; e < 4; ++e) { rp[e] = a0[e]; rp[64 + e] = a1[e]; rp[128 + e] = a2[e]; rp[192 + e] = a3[e]; rp[256 + e] = a4[e]; }
            __syncthreads();
            if (tid < 320) { float s = 0.f;
#pragma unroll 8
                for (int k = 0; k < 32; ++k) s += red[k * 320 + tid];
                const int j = tid >> 6, cc = tid & 63;
                ((float*)(p.ws + WS_MOD))[(size_t)(l * 5 + j) * 6144 + cch * 64 + cc] = s + PIN(I_BADA)[l * 6144 + cch * 64 + cc]; }
            __syncthreads();
        }
        __syncthreads();
    }
    {
        LAS float* scr = (LAS float*)(lds + wave * 8448);
        const int gw = get_bid() * 8 + wave, NGW = G * 8;
        constexpr int I_IN = 16 * 89, I_MG = 16 * 128, I_BRN = 4 * 32, I_BR = 4 * I_BRN, I_OUT = 16 * 32, I_M1 = 16 * 128, I_M2 = 64 * 32, I_GLU = 4 * 16;
        constexpr int I_LAYER = I_IN + I_MG + I_BR + I_OUT + I_M1 + I_M2 + I_GLU;
        for (int it = gw; it < 4 * I_LAYER; it += NGW) {
            const int l = it / I_LAYER; int r = it % I_LAYER;
            unsigned char* wl = p.ws + WS_W + (size_t)l * WL_STRIDE;
            if (r < I_IN) { const int kb = r / 89, nb = r % 89, n0 = nb * 32; const int dr = (n0 < 2048) ? n0 : (n0 == 2048 ? C_GLR : n0 - 32);
                transpose_item(PIN(I_WIN) + (size_t)l * 1024 * 2848, 2848, (bf16_t*)(wl + WL_CAT), 1024, dr, kb * 64, n0, scr, lane); continue; } r -= I_IN;
            if (r < I_MG) { const int kb = r / 128, nb = r % 128;
                transpose_item(PIN(I_WMG) + (size_t)l * 1024 * 4096, 4096, (bf16_t*)(wl + WL_CAT), 1024, 3072 + nb * 32, kb * 64, nb * 32, scr, lane); continue; } r -= I_MG;
            if (r < I_BR) { const int n = r / I_BRN, rr = r % I_BRN, kb = rr / 32, nb = rr % 32;
                transpose_item(PIN(I_WBR) + ((size_t)l * 4 + n) * 256 * 1024, 1024, (bf16_t*)(wl + WL_BR), 256, n * 1024 + nb * 32, kb * 64, nb * 32, scr, lane); continue; } r -= I_BR;
            if (r < I_OUT) { const int kb = r / 32, nb = r % 32;
                transpose_item(PIN(I_WOUT) + (size_t)l * 1024 * 1024, 1024, (bf16_t*)(wl + WL_OUT), 1024, nb * 32, kb * 64, nb * 32, scr, lane); continue; } r -= I_OUT;
            if (r < I_M1) { const int kb = r / 128, nb = r % 128;
                transpose_item(PIN(I_W1) + (size_t)l * 1024 * 4096, 4096, (bf16_t*)(wl + WL_M1), 1024, nb * 32, kb * 64, nb * 32, scr, lane); continue; } r -= I_M1;
            if (r < I_M2) { const int kb = r / 32, nb = r % 32;
                transpose_item(PIN(I_W2) + (size_t)l * 4096 * 1024, 1024, (bf16_t*)(wl + WL_M2), 4096, nb * 32, kb * 64, nb * 32, scr, lane); continue; } r -= I_M2;
            { const int kb = r / 16, nb = r % 16;
                transpose_item(PIN(I_S5WG) + (size_t)l * 256 * 512, 512, (bf16_t*)(wl + WL_GLU), 256, nb * 32, kb * 64, nb * 32, scr, lane); }
        }
        const int gt = get_bid() * 512 + tid, NT = G * 512;
        for (int i = gt; i < 4 * 28672; i += NT) { const int l = i / 28672, o = i % 28672;
            *(u32x4*)(p.ws + WS_W + (size_t)l * WL_STRIDE + WL_CAT + (size_t)2848 * 2048 + (size_t)o * 16) = (u32x4){0u, 0u, 0u, 0u}; }
    }
}

__device__ __forceinline__ void row_phase(const Ctx& p, int l, int mode) {
    const int tid = get_tid(), lane = tid & 63, wave = tid >> 6;
    const int gw = get_bid() * 8 + wave, NGW = get_nb() * 8;
    float* xbuf = p.out + O_X;
    const bf16_t* part = (const bf16_t*)(p.ws + WS_PART);
    const float* mod = (const float*)(p.ws + WS_MOD);
    bf16_t* H = (bf16_t*)(p.ws + WS_H);
    for (int row = gw; row < T_ALL; row += NGW) {
        const int mj = (row < T_CTX) ? 0 : 1 + ((row - T_CTX) >> 10);
        f32x4 x[4];
        if (mode == 0 && l == 0) {
            const float* src = (row < T_CTX) ? PIN(I_XP) + (size_t)row * DM : PIN(I_XS) + (size_t)(row - T_CTX) * DM;
#pragma unroll
            for (int j = 0; j < 4; ++j) x[j] = *(const f32x4*)(src + 256 * j + 4 * lane);
        } else {
            const int lp = (mode == 0) ? l - 1 : l, np = (mode == 0) ? 3 : 1, gsl = (mode == 0) ? 5 : 2;
            f32x4 f[4]; float ss = 0.f;
#pragma unroll
            for (int j = 0; j < 4; ++j) { const u32x2 pa = *(const u32x2*)(part + (size_t)row * DM + 256 * j + 4 * lane), pb = *(const u32x2*)(part + (size_t)(T_ALL + row) * DM + 256 * j + 4 * lane);
                f[j] = (f32x4){bflo(pa.x) + bflo(pb.x), bfhi(pa.x) + bfhi(pb.x), bflo(pa.y) + bflo(pb.y), bfhi(pa.y) + bfhi(pb.y)};
                ss += (f[j][0] * f[j][0] + f[j][1] * f[j][1]) + (f[j][2] * f[j][2] + f[j][3] * f[j][3]); }
            const float rstd = rsqrtf(wave_sum(ss) * (1.f / DM) + EPS);
#pragma unroll
            for (int j = 0; j < 4; ++j) { const int col = 256 * j + 4 * lane;
                const f32x4 gn = *(const f32x4*)(PIN(I_GN) + (size_t)(lp * 4 + np) * DM + col);
                const f32x4 gt = *(const f32x4*)(mod + (size_t)(lp * 5 + mj) * 6144 + gsl * DM + col);
                x[j] = *(const f32x4*)(xbuf + (size_t)row * DM + col) + gt * (f[j] * rstd * gn); }
        }
#pragma unroll
        for (int j = 0; j < 4; ++j) *(f32x4*)(xbuf + (size_t)row * DM + 256 * j + 4 * lane) = x[j];
        if (!(mode == 0 && l == 4)) {
            float ss = 0.f;
#pragma unroll
            for (int j = 0; j < 4; ++j) ss += (x[j][0] * x[j][0] + x[j][1] * x[j][1]) + (x[j][2] * x[j][2] + x[j][3] * x[j][3]);
            const float rstd = rsqrtf(wave_sum(ss) * (1.f / DM) + EPS);
            const int nh = (mode == 0) ? 0 : 2, shs = (mode == 0) ? 0 : 3, scs = (mode == 0) ? 1 : 4;
#pragma unroll
            for (int j = 0; j < 4; ++j) { const int col = 256 * j + 4 * lane;
                const f32x4 gn = *(const f32x4*)(PIN(I_GN) + (size_t)(l * 4 + nh) * DM + col);
                const f32x4 sh = *(const f32x4*)(mod + (size_t)(l * 5 + mj) * 6144 + shs * DM + col);
                const f32x4 sc = *(const f32x4*)(mod + (size_t)(l * 5 + mj) * 6144 + scs * DM + col);
                const f32x4 hv = (x[j] * rstd * gn) * (1.f + sc) + sh;
                u32x2 o; o.x = pk2(hv[0], hv[1]); o.y = pk2(hv[2], hv[3]);
                *(u32x2*)(H + (size_t)row * DM + col) = o; }
        }
    }
}

__device__ __forceinline__ void rope8(const float (&x)[8], const float (&xp)[8], int d0, int s, float (&o)[8]) {
    const float pos = (float)((d0 < 32) ? (s >> 6) : (s & 63));
    const float sgn = (d0 & 16) ? 1.f : -1.f;
#pragma unroll
    for (int e = 0; e < 8; ++e) { const int f = (d0 & 15) + e; const float ang = pos * exp2f(-0.8304820237f * (float)f);
        float sn, cs; __sincosf(ang, &sn, &cs); o[e] = x[e] * cs + sgn * xp[e] * sn; }
}
__device__ __forceinline__ void load_qk8(const bf16_t* proj, int t, int colbase, int d0, bool rope, int s, float (&o)[8]) {
    const bf16_t* rowp = proj + (size_t)t * NPROJ + colbase;
    float x[8]; unpack8(*(const u32x4*)(rowp + d0), x);
    if (!rope) {
#pragma unroll
        for (int e = 0; e < 8; ++e) o[e] = x[e];
        return;
    }
    float xp[8]; unpack8(*(const u32x4*)(rowp + (d0 ^ 16)), xp);
    rope8(x, xp, d0, s, o);
}

__device__ __forceinline__ int ret_sidx(int path, int b, int h, int dir, int c) { return path ? 512 + ((b * 4 + h) * 2 + dir) * 16 + c : ((b * 4 + h) * 2 + dir) * 4 + c; }

__device__ __forceinline__ void ret_state_item(const Ctx& p, int l, int path, int b, int h, int dir, LAS unsigned char* lds) {
    const int tid = get_tid(), lane = tid & 63, w = tid >> 6, r = lane & 15, q = lane >> 4;
    LAS bf16_t* KdT0 = (LAS bf16_t*)lds; LAS bf16_t* VT0 = KdT0 + 2 * 64 * 72;
    const bf16_t* proj = (const bf16_t*)(p.ws + WS_PROJ);
    bf16_t* rets = (bf16_t*)(p.ws + WS_RETS);
    const int nch = path ? 16 : 4, tok0 = path ? T_CTX + b * 1024 : b * 256;
    const float lg = PIN(I_RLD)[(l * 2 + dir) * 4 + h], cdec = __expf(lg * 64.f);
    const int rb = w >> 1, cb0 = (w & 1) * 2;
    f32x4 acc[2];
#pragma unroll
    for (int i = 0; i < 2; ++i)
#pragma unroll
        for (int e = 0; e < 4; ++e) { const int dv = rb * 16 + q * 4 + e, dk = (cb0 + i) * 16 + r;
            acc[i][e] = path ? PIN(I_SRET)[((size_t)(((b * 4 + l) * 2 + dir) * 4 + h) * 64 + dk) * 64 + dv] : 0.f; }
    const int j = tid >> 3, d0 = (tid & 7) * 8;
    u32x4 kraw, kpar, vraw;
    { const int c0 = dir ? nch - 1 : 0; const bf16_t* rp = proj + (size_t)(tok0 + c0 * 64 + j) * NPROJ + h * 64;
      kraw = *(const u32x4*)(rp + C_RK + d0); kpar = *(const u32x4*)(rp + C_RK + (d0 ^ 16)); vraw = *(const u32x4*)(rp + C_RV + d0); }
    for (int ci = 0; ci < nch; ++ci) {
        const int c = dir ? nch - 1 - ci : ci;
        bf16_t* sd = rets + (size_t)ret_sidx(path, b, h, dir, c) * 4096;
#pragma unroll
        for (int i = 0; i < 2; ++i)
#pragma unroll
            for (int e = 0; e < 4; ++e) sd[(rb * 16 + q * 4 + e) * 64 + (cb0 + i) * 16 + r] = f2bf(acc[i][e]);
        const int s = c * 64 + j;
        float kx[8], kp[8], kv[8], vv[8];
        unpack8(kraw, kx); unpack8(kpar, kp); unpack8(vraw, vv);
        if (path) rope8(kx, kp, d0, s, kv); else {
#pragma unroll
            for (int e = 0; e < 8; ++e) kv[e] = kx[e]; }
        if (ci + 1 < nch) { const int cn = dir ? nch - 2 - ci : ci + 1; const bf16_t* rp = proj + (size_t)(tok0 + cn * 64 + j) * NPROJ + h * 64;
            kraw = *(const u32x4*)(rp + C_RK + d0); kpar = *(const u32x4*)(rp + C_RK + (d0 ^ 16)); vraw = *(const u32x4*)(rp + C_RV + d0); }
        const float wj = 0.125f * __expf(lg * (float)(dir ? j : 63 - j));
        LAS bf16_t* KdT = KdT0 + (ci & 1) * (64 * 72); LAS bf16_t* VT = VT0 + (ci & 1) * (64 * 72);
#pragma unroll
        for (int e = 0; e < 8; ++e) { KdT[(d0 + e) * 72 + j] = f2bf(kv[e] * wj); VT[(d0 + e) * 72 + j] = f2bf(vv[e]); }
        __syncthreads();
#pragma unroll
        for (int i = 0; i < 2; ++i) { acc[i] *= cdec; acc[i] = mma_k<2>(VT, 72, rb * 16, 0, KdT, 72, (cb0 + i) * 16, 0, acc[i], lane); }
    }
    __syncthreads();
    if (!path) {
#pragma unroll
        for (int i = 0; i < 2; ++i)
#pragma unroll
            for (int e = 0; e < 4; ++e) { const int dv = rb * 16 + q * 4 + e, dk = (cb0 + i) * 16 + r;
                p.out[O_RET + ((size_t)(((b * 4 + l) * 2 + dir) * 4 + h) * 64 + dk) * 64 + dv] = acc[i][e]; }
    }
}

__device__ __forceinline__ void headnorm_store(const LAS float* O, const float* gn, const bf16_t* gaterow, bf16_t* dst, int tid) {
    const int i = tid >> 3, sub = tid & 7;
    float v[8]; float s = 0.f;
#pragma unroll
    for (int e = 0; e < 8; ++e) { v[e] = O[i * 65 + sub * 8 + e]; s += v[e]; }
    s += __shfl_xor(s, 1); s += __shfl_xor(s, 2); s += __shfl_xor(s, 4);
    const float mu = s * (1.f / 64.f); float qv = 0.f;
#pragma unroll
    for (int e = 0; e < 8; ++e) { v[e] -= mu; qv += v[e] * v[e]; }
    qv += __shfl_xor(qv, 1); qv += __shfl_xor(qv, 2); qv += __shfl_xor(qv, 4);
    const float rstd = rsqrtf(qv * (1.f / 64.f) + EPS);
    float g[8]; unpack8(*(const u32x4*)(gaterow + sub * 8), g);
    float o[8];
#pragma unroll
    for (int e = 0; e < 8; ++e) o[e] = v[e] * rstd * gn[sub * 8 + e] * siluf_(g[e]);
    *(u32x4*)(dst + sub * 8) = pack8(o);
}

__device__ __forceinline__ void ret_out_item(const Ctx& p, int l, int path, int b, int h, int c, LAS unsigned char* lds) {
    const int tid = get_tid(), lane = tid & 63, w = tid >> 6, r = lane & 15, q = lane >> 4;
    LAS bf16_t* Q = (LAS bf16_t*)lds; LAS bf16_t* Kk = Q + 64 * 72; LAS bf16_t* VT = Kk + 64 * 72; LAS bf16_t* P = VT + 64 * 72;
    LAS bf16_t* QD = P + 64 * 72; LAS bf16_t* ST = QD + 64 * 136; LAS float* O = (LAS float*)(ST + 64 * 136);
    const bf16_t* proj = (const bf16_t*)(p.ws + WS_PROJ);
    const bf16_t* rets = (const bf16_t*)(p.ws + WS_RETS);
    const int tok0 = path ? T_CTX + b * 1024 : b * 256;
    const float lgf = PIN(I_RLD)[(l * 2 + 0) * 4 + h], lgb = PIN(I_RLD)[(l * 2 + 1) * 4 + h];
    {
        const int j = tid >> 3, d0 = (tid & 7) * 8, s = c * 64 + j, t = tok0 + s;
        float qv[8], kv[8], vv[8];
        load_qk8(proj, t, C_RQ + h * 64, d0, path != 0, s, qv);
        load_qk8(proj, t, C_RK + h * 64, d0, path != 0, s, kv);
        unpack8(*(const u32x4*)(proj + (size_t)t * NPROJ + C_RV + h * 64 + d0), vv);
        const float qf = __expf(lgf * (float)(j + 1)), qb = __expf(lgb * (float)(64 - j));
        float t0[8], t1[8], t2[8];
#pragma unroll
        for (int e = 0; e < 8; ++e) { kv[e] *= 0.125f; t0[e] = qv[e] * qf; t1[e] = qv[e] * qb; t2[e] = vv[e]; }
        *(LAS u32x4*)(Q + j * 72 + d0) = pack8(qv);
        *(LAS u32x4*)(Kk + j * 72 + d0) = pack8(kv);
        *(LAS u32x4*)(QD + j * 136 + d0) = pack8(t0);
        *(LAS u32x4*)(QD + j * 136 + 64 + d0) = pack8(t1);
#pragma unroll
        for (int e = 0; e < 8; ++e) VT[(d0 + e) * 72 + j] = f2bf(t2[e]);
        const u32x4 sf = *(const u32x4*)(rets + (size_t)ret_sidx(path, b, h, 0, c) * 4096 + tid * 8);
        const u32x4 sb = *(const u32x4*)(rets + (size_t)ret_sidx(path, b, h, 1, c) * 4096 + tid * 8);
        *(LAS u32x4*)(ST + j * 136 + d0) = sf;
        *(LAS u32x4*)(ST + j * 136 + 64 + d0) = sb;
    }
    __syncthreads();
    const int rb = w >> 1, cb0 = (w & 1) * 2;
#pragma unroll
    for (int i = 0; i < 2; ++i) {
        f32x4 a = {0.f, 0.f, 0.f, 0.f};
        a = mma_k<2>(Q, 72, rb * 16, 0, Kk, 72, (cb0 + i) * 16, 0, a, lane);
#pragma unroll
        for (int e = 0; e < 4; ++e) { const int ii = rb * 16 + q * 4 + e, jj = (cb0 + i) * 16 + r;
            float wgt = 0.f;
            if (jj <= ii) wgt += __expf(lgf * (float)(ii - jj));
            if (jj >= ii) wgt += __expf(lgb * (float)(jj - ii));
            P[ii * 72 + jj] = f2bf(a[e] * wgt); }
    }
    __syncthreads();
#pragma unroll
    for (int i = 0; i < 2; ++i) {
        f32x4 a = {0.f, 0.f, 0.f, 0.f};
        a = mma_k<2>(P, 72, rb * 16, 0, VT, 72, (cb0 + i) * 16, 0, a, lane);
        a = mma_k<4>(QD, 136, rb * 16, 0, ST, 136, (cb0 + i) * 16, 0, a, lane);
#pragma unroll
        for (int e = 0; e < 4; ++e) O[(rb * 16 + q * 4 + e) * 65 + (cb0 + i) * 16 + r] = a[e];
    }
    __syncthreads();
    {
        const int i = tid >> 3, t = tok0 + c * 64 + i;
        headnorm_store(O, PIN(I_RGN) + l * 256 + h * 64, proj + (size_t)t * NPROJ + C_RG + h * 64, (bf16_t*)(p.ws + WS_BR) + (size_t)t * DM + 0 * 256 + h * 64, tid);
    }
    __syncthreads();
}

__device__ __forceinline__ void gla_cum(const Ctx& p, int l, int dir, int h, u32x4 lra, u32x4 lrb, LAS float* Bc, LAS float* BEND) {
    const int tid = get_tid(), lane = tid & 63, w = tid >> 6;
    {
        const int j = tid >> 3, dd = (tid & 7) * 4;
        float lr[16]; { float a[8], b2[8]; unpack8(lra, a); unpack8(lrb, b2);
#pragma unroll
            for (int e = 0; e < 8; ++e) { lr[e] = a[e]; lr[8 + e] = b2[e]; } }
        const float* wg = PIN(I_GWG) + (size_t)(l * 2 + dir) * 16 * 128 + h * 32 + dd;
        f32x4 z = *(const f32x4*)(PIN(I_GBG) + (l * 2 + dir) * 128 + h * 32 + dd);
#pragma unroll
        for (int rr = 0; rr < 16; ++rr) z += lr[rr] * *(const f32x4*)(wg + rr * 128);
#pragma unroll
        for (int e = 0; e < 4; ++e) { const float x = z[e]; const float ls = fminf(x, 0.f) - __logf(1.f + __expf(-fabsf(x))); Bc[j * 33 + dd + e] = ls * (1.f / 16.f); }
    }
    __syncthreads();
    {
        const int pos = dir ? 63 - lane : lane;
#pragma unroll
        for (int k = 0; k < 4; ++k) { const int d = w * 4 + k; float v = Bc[pos * 33 + d];
#pragma unroll
            for (int off = 1; off < 64; off <<= 1) { const float tv = __shfl_up(v, off); if (lane >= off) v += tv; }
            Bc[pos * 33 + d] = v; if (lane == 63) BEND[d] = v; }
    }
    __syncthreads();
}

__device__ __forceinline__ int gla_sidx(int path, int b, int h, int dir, int c) { return ret_sidx(path, b, h, dir, c); }

__device__ __forceinline__ void gla_state_item(const Ctx& p, int l, int path, int b, int h, int dir, LAS unsigned char* lds) {
    const int tid = get_tid(), lane = tid & 63, w = tid >> 6, r = lane & 15, q = lane >> 4;
    LAS bf16_t* KdT0 = (LAS bf16_t*)lds; LAS bf16_t* VT0 = KdT0 + 2 * 32 * 72; LAS float* Bc0 = (LAS float*)(VT0 + 2 * 64 * 72); LAS float* BEND0 = Bc0 + 2 * 64 * 33;
    const bf16_t* proj = (const bf16_t*)(p.ws + WS_PROJ);
    bf16_t* glas = (bf16_t*)(p.ws + WS_GLAS);
    const int nch = path ? 16 : 4, tok0 = path ? T_CTX + b * 1024 : b * 256;
    const int rb = w >> 1, cb = w & 1;
    f32x4 acc;
#pragma unroll
    for (int e = 0; e < 4; ++e) { const int dv = rb * 16 + q * 4 + e, dk = cb * 16 + r;
        acc[e] = path ? PIN(I_SGLA)[((size_t)(((b * 4 + l) * 2 + dir) * 4 + h) * 32 + dk) * 64 + dv] : 0.f; }
    const int j = tid >> 3, dd = (tid & 7) * 4, d0 = (tid & 7) * 8;
    u32x4 lra, lrb, vraw; u32x2 kw;
    { const int c0 = dir ? nch - 1 : 0; const bf16_t* rp = proj + (size_t)(tok0 + c0 * 64 + j) * NPROJ;
      lra = *(const u32x4*)(rp + C_GLR + dir * 16); lrb = *(const u32x4*)(rp + C_GLR + dir * 16 + 8); kw = *(const u32x2*)(rp + C_GK + h * 32 + dd); vraw = *(const u32x4*)(rp + C_GV + h * 64 + d0); }
    for (int ci = 0; ci < nch; ++ci) {
        const int c = dir ? nch - 1 - ci : ci;
        LAS bf16_t* KdT = KdT0 + (ci & 1) * (32 * 72); LAS bf16_t* VT = VT0 + (ci & 1) * (64 * 72); LAS float* Bc = Bc0 + (ci & 1) * (64 * 33); LAS float* BEND = BEND0 + (ci & 1) * 32;
        gla_cum(p, l, dir, h, lra, lrb, Bc, BEND);
        bf16_t* sd = glas + (size_t)gla_sidx(path, b, h, dir, c) * 2048;
#pragma unroll
        for (int e = 0; e < 4; ++e) sd[(rb * 16 + q * 4 + e) * 32 + cb * 16 + r] = f2bf(acc[e]);
        {
            const float kf[4] = {bflo(kw.x), bfhi(kw.x), bflo(kw.y), bfhi(kw.y)};
#pragma unroll
            for (int e = 0; e < 4; ++e) KdT[(dd + e) * 72 + j] = f2bf(kf[e] * __expf(BEND[dd + e] - Bc[j * 33 + dd + e]));
            float vv[8]; unpack8(vraw, vv);
#pragma unroll
            for (int e = 0; e < 8; ++e) VT[(d0 + e) * 72 + j] = f2bf(vv[e]);
        }
        if (ci + 1 < nch) { const int cn = dir ? nch - 2 - ci : ci + 1; const bf16_t* rp = proj + (size_t)(tok0 + cn * 64 + j) * NPROJ;
            lra = *(const u32x4*)(rp + C_GLR + dir * 16); lrb = *(const u32x4*)(rp + C_GLR + dir * 16 + 8); kw = *(const u32x2*)(rp + C_GK + h * 32 + dd); vraw = *(const u32x4*)(rp + C_GV + h * 64 + d0); }
        __syncthreads();
        acc *= __expf(BEND[cb * 16 + r]);
        acc = mma_k<2>(VT, 72, rb * 16, 0, KdT, 72, cb * 16, 0, acc, lane);
    }
    __syncthreads();
    if (!path) {
#pragma unroll
        for (int e = 0; e < 4; ++e) { const int dv = rb * 16 + q * 4 + e, dk = cb * 16 + r;
            p.out[O_GLA + ((size_t)(((b * 4 + l) * 2 + dir) * 4 + h) * 32 + dk) * 64 + dv] = acc[e]; }
    }
}

__device__ __forceinline__ void gla_out_item(const Ctx& p, int l, int path, int b, int h, int c, LAS unsigned char* lds) {
    const int tid = get_tid(), lane = tid & 63, w = tid >> 6, r = lane & 15, q = lane >> 4;
    LAS bf16_t* QD = (LAS bf16_t*)lds; LAS bf16_t* KD = QD + 64 * 72; LAS bf16_t* VT = KD + 64 * 72; LAS bf16_t* P = VT + 64 * 72; LAS bf16_t* ST = P + 64 * 72;
    LAS float* O = (LAS float*)(ST + 64 * 72); LAS float* BcF = O + 64 * 65; LAS float* BcB = BcF + 64 * 33; LAS float* BEND = BcB + 64 * 33;
    const bf16_t* proj = (const bf16_t*)(p.ws + WS_PROJ);
    const bf16_t* glas = (const bf16_t*)(p.ws + WS_GLAS);
    const int tok0 = path ? T_CTX + b * 1024 : b * 256, tc0 = tok0 + c * 64;
    { const bf16_t* rp = proj + (size_t)(tc0 + (tid >> 3)) * NPROJ + C_GLR; const u32x4 l0 = *(const u32x4*)rp, l1 = *(const u32x4*)(rp + 8), l2 = *(const u32x4*)(rp + 16), l3 = *(const u32x4*)(rp + 24);
      gla_cum(p, l, 0, h, l0, l1, BcF, BEND);
      gla_cum(p, l, 1, h, l2, l3, BcB, BEND); }
    {
        const int j = tid >> 3, t = tc0 + j, dd = (tid & 7) * 4;
        const u32x2 qw = *(const u32x2*)(proj + (size_t)t * NPROJ + C_GQ + h * 32 + dd);
        const u32x2 kw = *(const u32x2*)(proj + (size_t)t * NPROJ + C_GK + h * 32 + dd);
        const float qf[4] = {bflo(qw.x), bfhi(qw.x), bflo(qw.y), bfhi(qw.y)}, kf[4] = {bflo(kw.x), bfhi(kw.x), bflo(kw.y), bfhi(kw.y)};
        const float qs = 0.17677669529663687f;
        float a0[4], a1[4], a2[4], a3[4];
#pragma unroll
        for (int e = 0; e < 4; ++e) { const float bf_ = BcF[j * 33 + dd + e], bb_ = BcB[j * 33 + dd + e];
            a0[e] = qf[e] * qs * __expf(bf_); a1[e] = qf[e] * qs * __expf(bb_); a2[e] = kf[e] * __expf(-bf_); a3[e] = kf[e] * __expf(-bb_); }
        u32x2 o; o.x = pk2(a0[0], a0[1]); o.y = pk2(a0[2], a0[3]); *(LAS u32x2*)(QD + j * 72 + dd) = o;
        o.x = pk2(a1[0], a1[1]); o.y = pk2(a1[2], a1[3]); *(LAS u32x2*)(QD + j * 72 + 32 + dd) = o;
        o.x = pk2(a2[0], a2[1]); o.y = pk2(a2[2], a2[3]); *(LAS u32x2*)(KD + j * 72 + dd) = o;
        o.x = pk2(a3[0], a3[1]); o.y = pk2(a3[2], a3[3]); *(LAS u32x2*)(KD + j * 72 + 32 + dd) = o;
        const int d0 = (tid & 7) * 8; float vv[8]; unpack8(*(const u32x4*)(proj + (size_t)t * NPROJ + C_GV + h * 64 + d0), vv);
#pragma unroll
        for (int e = 0; e < 8; ++e) VT[(d0 + e) * 72 + j] = f2bf(vv[e]);
        const int dir = tid >> 8, idx = (tid & 255) * 8, dv = idx >> 5, dk0 = idx & 31;
        *(LAS u32x4*)(ST + dv * 72 + dir * 32 + dk0) = *(const u32x4*)(glas + (size_t)gla_sidx(path, b, h, dir, c) * 2048 + idx);
    }
    __syncthreads();
    const int rb = w >> 1, cb0 = (w & 1) * 2;
#pragma unroll
    for (int i = 0; i < 2; ++i) {
        f32x4 af = {0.f, 0.f, 0.f, 0.f}, ab = af;
        af = mma_k<1>(QD, 72, rb * 16, 0, KD, 72, (cb0 + i) * 16, 0, af, lane);
        ab = mma_k<1>(QD, 72, rb * 16, 32, KD, 72, (cb0 + i) * 16, 32, ab, lane);
#pragma unroll
        for (int e = 0; e < 4; ++e) { const int ii = rb * 16 + q * 4 + e, jj = (cb0 + i) * 16 + r;
            float v = 0.f; if (jj <= ii) v += af[e]; if (jj >= ii) v += ab[e];
            P[ii * 72 + jj] = f2bf(v); }
    }
    __syncthreads();
#pragma unroll
    for (int i = 0; i < 2; ++i) {
        f32x4 a = {0.f, 0.f, 0.f, 0.f};
        a = mma_k<2>(P, 72, rb * 16, 0, VT, 72, (cb0 + i) * 16, 0, a, lane);
        a = mma_k<2>(QD, 72, rb * 16, 0, ST, 72, (cb0 + i) * 16, 0, a, lane);
#pragma unroll
        for (int e = 0; e < 4; ++e) O[(rb * 16 + q * 4 + e) * 65 + (cb0 + i) * 16 + r] = a[e];
    }
    __syncthreads();
    {
        const int i = tid >> 3, t = tc0 + i;
        headnorm_store(O, PIN(I_GGN) + l * 256 + h * 64, proj + (size_t)t * NPROJ + C_GG + h * 64, (bf16_t*)(p.ws + WS_BR) + (size_t)t * DM + 2 * 256 + h * 64, tid);
    }
    __syncthreads();
}

__device__ __forceinline__ size_t s5e_idx(int slot, int dir, int g, int seg) { return ((size_t)((slot * 2 + dir) * 16 + g) * 16 + seg) * 128; }
__device__ __forceinline__ void s5_item(const Ctx& p, int l, int path, int b, int dir, int gset, int seg0, LAS unsigned char* lds) {
    const int tid = get_tid(), lane = tid & 63, w = tid >> 6, r = lane & 15, q = lane >> 4;
    const int g = gset * 8 + w;
    LAS unsigned char* wl = lds + w * 16384;
    LAS bf16_t* U = (LAS bf16_t*)wl;
    LAS float* BU = (LAS float*)(wl + 1280);
    LAS bf16_t* XS = (LAS bf16_t*)(wl + 1280 + 8448);
    const bf16_t* proj = (const bf16_t*)(p.ws + WS_PROJ);
    float* s5y = (float*)(p.ws + WS_S5Y) + (size_t)dir * T_ALL * 256;
    const int tokb = (path ? T_CTX + b * 1024 : b * 256);
    const int ldg = (l * 2 + dir) * 16 + g;
    const float dt = __expf(PIN(I_S5DT)[ldg]);
    float ar, ai;
    { const float lre = PIN(I_S5LR)[ldg * 64 + lane], lim = PIN(I_S5LI)[ldg * 64 + lane]; const float m = __expf(lre * dt); float sn, cs; sincosf(lim * dt, &sn, &cs); ar = m * cs; ai = m * sn; }
    bf16x8 bfrag[8];
#pragma unroll
    for (int ct = 0; ct < 8; ++ct) {
        const int ps = (ct & 3) * 16 + r;
        const float lre = PIN(I_S5LR)[ldg * 64 + ps], lim = PIN(I_S5LI)[ldg * 64 + ps];
        const float m = __expf(lre * dt); float sn, cs; sincosf(lim * dt, &sn, &cs);
        const float nr = m * cs - 1.f, ni = m * sn, den = 1.f / (lre * lre + lim * lim);
        const float cr = (nr * lre + ni * lim) * den, cim = (ni * lre - nr * lim) * den;
        float vals[8];
        if (q < 2) {
            const float* br = PIN(I_S5BR) + ((size_t)ldg * 64 + ps) * 16 + q * 8; const float* bi = PIN(I_S5BI) + ((size_t)ldg * 64 + ps) * 16 + q * 8;
#pragma unroll
            for (int e = 0; e < 8; ++e) vals[e] = (ct < 4) ? (cr * br[e] - cim * bi[e]) : (cr * bi[e] + cim * br[e]);
        } else {
#pragma unroll
            for (int e = 0; e < 8; ++e) vals[e] = 0.f;
        }
        const u32x4 pk = pack8(vals); bfrag[ct] = *(const bf16x8*)&pk;
    }
    bf16x8 cfrag[4];
#pragma unroll
    for (int ks = 0; ks < 4; ++ks) {
        const int k0 = ks * 32 + q * 8; float vals[8];
        const float* src = (k0 < 64) ? PIN(I_S5CR) + ((size_t)ldg * 16 + r) * 64 + k0 : PIN(I_S5CI) + ((size_t)ldg * 16 + r) * 64 + (k0 - 64);
#pragma unroll
        for (int e = 0; e < 8; ++e) vals[e] = (k0 < 64) ? src[e] : -src[e];
        const u32x4 pk = pack8(vals); cfrag[ks] = *(const bf16x8*)&pk;
    }
    for (int i = lane; i < 16 * 40; i += 64) U[i] = 0;
    LDS_WAIT();
#pragma unroll 1
    for (int sg = 0; sg < 4; ++sg) {
    const int seg = seg0 + sg, tok0 = tokb + seg * 64;
    float xr = 0.f, xi = 0.f;
    const int ujj = (lane & 31) >> 1, uhalf = lane & 1;
    u32x4 unext;
    { const int pp = ujj, ti = dir ? 63 - pp : pp; unext = *(const u32x4*)(proj + (size_t)(tok0 + ti) * NPROJ + C_SU + g * 16 + uhalf * 8); }
#pragma unroll 1
    for (int sc = 0; sc < 4; ++sc) {
        if (lane < 32) *(LAS u32x4*)(U + ujj * 40 + uhalf * 8) = unext;
        if (sc + 1 < 4) { const int pp = (sc + 1) * 16 + ujj, ti = dir ? 63 - pp : pp; unext = *(const u32x4*)(proj + (size_t)(tok0 + ti) * NPROJ + C_SU + g * 16 + uhalf * 8); }
        LDS_WAIT();
        const bf16x8 afr = *(const LAS bf16x8*)(U + r * 40 + q * 8);
#pragma unroll
        for (int ct = 0; ct < 8; ++ct) { f32x4 a = {0.f, 0.f, 0.f, 0.f}; a = __builtin_amdgcn_mfma_f32_16x16x32_bf16(afr, bfrag[ct], a, 0, 0, 0);
#pragma unroll
            for (int e = 0; e < 4; ++e) BU[(q * 4 + e) * 132 + ct * 16 + r] = a[e]; }
        LDS_WAIT();
#pragma unroll
        for (int jj = 0; jj < 16; ++jj) { const float bur = BU[jj * 132 + lane], bui = BU[jj * 132 + 64 + lane];
            const float nr = ar * xr - ai * xi + bur, ni = ar * xi + ai * xr + bui; xr = nr; xi = ni;
            XS[jj * 136 + lane] = f2bf(xr); XS[jj * 136 + 64 + lane] = f2bf(xi); }
        LDS_WAIT();
        f32x4 y = {0.f, 0.f, 0.f, 0.f};
#pragma unroll
        for (int ks = 0; ks < 4; ++ks) { const bf16x8 xa = *(const LAS bf16x8*)(XS + r * 136 + ks * 32 + q * 8); y = __builtin_amdgcn_mfma_f32_16x16x32_bf16(xa, cfrag[ks], y, 0, 0, 0); }
#pragma unroll
        for (int e = 0; e < 4; ++e) { const int pp = sc * 16 + q * 4 + e, ti = dir ? 63 - pp : pp; s5y[(size_t)(tok0 + ti) * 256 + g * 16 + r] = y[e]; }
        LDS_WAIT();
    }
    { float* d = (float*)(p.ws + WS_S5E) + s5e_idx(path ? 16 + b : b, dir, g, seg) + lane * 2; d[0] = xr; d[1] = xi; }
    }

}

__device__ __forceinline__ void s5_glu_item(const Ctx& p, int l, int tile, LAS unsigned char* lds) {
    const int tid = get_tid(), lane = tid & 63, w = tid >> 6, r = lane & 15, q = lane >> 4;
    LAS bf16_t* GA = (LAS bf16_t*)lds;
    LAS bf16_t* Zw = GA + 64 * 264 + w * (16 * 136);
    const bf16_t* proj = (const bf16_t*)(p.ws + WS_PROJ);
    const float* yf = (const float*)(p.ws + WS_S5Y); const float* yb = yf + (size_t)T_ALL * 256;
    const float* s5e = (const float*)(p.ws + WS_S5E);
    const int t0 = tile * 64;
    const int path = tile >= 64 ? 1 : 0, tl = tile - 64;
    const int b = path ? tl >> 4 : tile >> 2, seg = path ? tl & 15 : tile & 3, nseg = path ? 16 : 4, slot = path ? 16 + b : b;
    f32x4 yc[2][4];
#pragma unroll
    for (int gi = 0; gi < 2; ++gi)
#pragma unroll
        for (int pc = 0; pc < 4; ++pc) yc[gi][pc] = (f32x4){0.f, 0.f, 0.f, 0.f};
#pragma unroll
    for (int gi = 0; gi < 2; ++gi) {
        const int g = 2 * w + gi;
#pragma unroll
        for (int dir = 0; dir < 2; ++dir) {
            const int ldg = (l * 2 + dir) * 16 + g;
            const float dt = __expf(PIN(I_S5DT)[ldg]);
            const float lre = PIN(I_S5LR)[ldg * 64 + lane], lim = PIN(I_S5LI)[ldg * 64 + lane];
            float ar, ai, ar64, ai64;
            { const float m = __expf(lre * dt); float sn, cs; sincosf(lim * dt, &sn, &cs); ar = m * cs; ai = m * sn; }
            { const float m = __expf(64.f * lre * dt); float sn, cs; sincosf(64.f * lim * dt, &sn, &cs); ar64 = m * cs; ai64 = m * sn; }
            float xr = 0.f, xi = 0.f;
            if (path) { const float* s0 = PIN(I_SS5) + ((size_t)(((b * 4 + l) * 2 + dir) * 16 + g) * 64 + lane) * 2; xr = s0[0]; xi = s0[1]; }
            const int nprev = dir ? nseg - 1 - seg : seg;
            { float er[15], ei[15];
#pragma unroll
              for (int k = 0; k < 15; ++k) { er[k] = 0.f; ei[k] = 0.f;
                  if (k < nprev) { const int sg = dir ? nseg - 1 - k : k; const float2 e = *(const float2*)(s5e + s5e_idx(slot, dir, g, sg) + lane * 2); er[k] = e.x; ei[k] = e.y; } }
#pragma unroll
              for (int k = 0; k < 15; ++k) if (k < nprev) { const float nr = ar64 * xr - ai64 * xi + er[k], ni = ar64 * xi + ai64 * xr + ei[k]; xr = nr; xi = ni; } }
            if (!path && seg == (dir ? 0 : nseg - 1)) {
                const float* e = s5e + s5e_idx(slot, dir, g, seg) + lane * 2;
                float* d = p.out + O_S5 + ((size_t)(((b * 4 + l) * 2 + dir) * 16 + g) * 64 + lane) * 2;
                d[0] = ar64 * xr - ai64 * xi + e[0]; d[1] = ar64 * xi + ai64 * xr + e[1]; }
            bf16x8 cfrag[4];
#pragma unroll
            for (int ks = 0; ks < 4; ++ks) {
                const int k0 = ks * 32 + q * 8; float vals[8];
                const float* src = (k0 < 64) ? PIN(I_S5CR) + ((size_t)ldg * 16 + r) * 64 + k0 : PIN(I_S5CI) + ((size_t)ldg * 16 + r) * 64 + (k0 - 64);
#pragma unroll
                for (int e = 0; e < 8; ++e) vals[e] = (k0 < 64) ? src[e] : -src[e];
                const u32x4 pk = pack8(vals); cfrag[ks] = *(const bf16x8*)&pk;
            }
            float zr = xr, zi = xi;
#pragma unroll
            for (int ppc = 0; ppc < 4; ++ppc) {
#pragma unroll 4
                for (int pj = 0; pj < 16; ++pj) { const float nr = ar * zr - ai * zi, ni = ar * zi + ai * zr; zr = nr; zi = ni;
                    const int row = dir ? 15 - pj : pj; Zw[row * 136 + lane] = f2bf(zr); Zw[row * 136 + 64 + lane] = f2bf(zi); }
                LDS_WAIT();
                f32x4 y = yc[gi][dir ? 3 - ppc : ppc];
#pragma unroll
                for (int ks = 0; ks < 4; ++ks) { const bf16x8 xa = *(const LAS bf16x8*)(Zw + r * 136 + ks * 32 + q * 8); y = __builtin_amdgcn_mfma_f32_16x16x32_bf16(xa, cfrag[ks], y, 0, 0, 0); }
                yc[gi][dir ? 3 - ppc : ppc] = y;
                LDS_WAIT();
            }
        }
    }
#pragma unroll
    for (int gi = 0; gi < 2; ++gi) {
        const int c = (2 * w + gi) * 16 + r; const float dsk = PIN(I_S5D)[l * 256 + c];
#pragma unroll
        for (int pc = 0; pc < 4; ++pc)
#pragma unroll
            for (int e = 0; e < 4; ++e) { const int i = pc * 16 + q * 4 + e, t = t0 + i;
                const float u = bf2f(proj[(size_t)t * NPROJ + C_SU + c]);
                const float y = yf[(size_t)t * 256 + c] + yb[(size_t)t * 256 + c] + yc[gi][pc][e] + dsk * u;
                const float inner = 0.7978845608028654f * (y + 0.044715f * y * y * y);
                GA[i * 264 + c] = f2bf(0.5f * y * (1.f + tanhf(inner))); }
    }
    __syncthreads();
    const bf16_t* wglu = (const bf16_t*)(p.ws + WS_W + (size_t)l * WL_STRIDE + WL_GLU);
    bf16_t* br = (bf16_t*)(p.ws + WS_BR);
#pragma unroll 1
    for (int ci = 0; ci < 2; ++ci) {
        const int cb = w + ci * 8;
        bf16x8 wa[8], wg[8];
#pragma unroll
        for (int ks = 0; ks < 8; ++ks) { wa[ks] = *(const bf16x8*)(wglu + (size_t)(cb * 16 + r) * 256 + ks * 32 + q * 8); wg[ks] = *(const bf16x8*)(wglu + (size_t)(256 + cb * 16 + r) * 256 + ks * 32 + q * 8); }
        const float ba = PIN(I_S5BG)[l * 512 + cb * 16 + r], bg = PIN(I_S5BG)[l * 512 + 256 + cb * 16 + r];
#pragma unroll 1
        for (int rb = 0; rb < 4; ++rb) {
            f32x4 aa = {0.f, 0.f, 0.f, 0.f}, ag = aa;
#pragma unroll
            for (int ks = 0; ks < 8; ++ks) { const bf16x8 af = *(const LAS bf16x8*)(GA + (rb * 16 + r) * 264 + ks * 32 + q * 8);
                aa = __builtin_amdgcn_mfma_f32_16x16x32_bf16(af, wa[ks], aa, 0, 0, 0); ag = __builtin_amdgcn_mfma_f32_16x16x32_bf16(af, wg[ks], ag, 0, 0, 0); }
#pragma unroll
            for (int e = 0; e < 4; ++e) { const int t = t0 + rb * 16 + q * 4 + e; br[(size_t)t * DM + 256 + cb * 16 + r] = f2bf((aa[e] + ba) * sigmoidf_(ag[e] + bg)); }
        }
    }
    __syncthreads();
}

__device__ __forceinline__ void na_item(const Ctx& p, int l, int kind, int b, int h, int qt, LAS unsigned char* lds) {
    const int tid = get_tid(), lane = tid & 63, w = tid >> 6, r = lane & 15, q = lane >> 4;
    LAS bf16_t* Qs = (LAS bf16_t*)lds; LAS bf16_t* Ks = Qs + 64 * 72; LAS bf16_t* VTs = Ks + 64 * 72; LAS bf16_t* Pb = VTs + 64 * 72;
    LAS float* Sb = (LAS float*)(Pb + 64 * 72); LAS float* ALPHA = Sb + 64 * 68; LAS float* LSUM = ALPHA + 64;
    const bf16_t* proj = (const bf16_t*)(p.ws + WS_PROJ);
    const int tq0 = kind ? T_CTX + b * 1024 + qt * 64 : b * 256 + qt * 64;
    const int nblk = kind ? 12 : 4;
    const int rs = kind ? min(max(qt - 4, 0), 8) : 0;
    const int j = tid >> 3, d0 = (tid & 7) * 8;
    *(LAS u32x4*)(Qs + j * 72 + d0) = *(const u32x4*)(proj + (size_t)(tq0 + j) * NPROJ + C_NQ + h * 64 + d0);
    const int rb = w >> 1, cb0 = (w & 1) * 2;
    f32x4 oacc[2] = {{0.f, 0.f, 0.f, 0.f}, {0.f, 0.f, 0.f, 0.f}};
    float mrun = -1e30f, lrun = 0.f;
    const float* rpb = PIN(I_RPB) + (size_t)(l * 4 + h) * 15 * 31;
    auto loadkv = [&](int blk, u32x4& kreg, u32x4& vreg) {
        if (kind == 0 || blk < 8) {
            const int tk = kind ? T_CTX + b * 1024 + (rs + blk) * 64 + j : b * 256 + blk * 64 + j;
            kreg = *(const u32x4*)(proj + (size_t)tk * NPROJ + C_NK + h * 64 + d0);
            vreg = *(const u32x4*)(proj + (size_t)tk * NPROJ + C_NV + h * 64 + d0);
        } else {
            const size_t off = ((size_t)((b * 4 + l) * 256 + (blk - 8) * 64 + j) * 4 + h) * 64 + d0;
            const f32x4 k0 = *(const f32x4*)(PIN(I_CK) + off), k1 = *(const f32x4*)(PIN(I_CK) + off + 4);
            const f32x4 v0 = *(const f32x4*)(PIN(I_CV) + off), v1 = *(const f32x4*)(PIN(I_CV) + off + 4);
            kreg.x = pk2(k0[0], k0[1]); kreg.y = pk2(k0[2], k0[3]); kreg.z = pk2(k1[0], k1[1]); kreg.w = pk2(k1[2], k1[3]);
            vreg.x = pk2(v0[0], v0[1]); vreg.y = pk2(v0[2], v0[3]); vreg.z = pk2(v1[0], v1[1]); vreg.w = pk2(v1[2], v1[3]);
        }
    };
    u32x4 knext, vnext;
    loadkv(0, knext, vnext);
    for (int blk = 0; blk < nblk; ++blk) {
        const u32x4 kreg = knext, vreg = vnext;
        *(LAS u32x4*)(Ks + j * 72 + d0) = kreg;
        if (blk + 1 < nblk) loadkv(blk + 1, knext, vnext);
        { const unsigned vw[4] = {vreg.x, vreg.y, vreg.z, vreg.w};
#pragma unroll
            for (int e = 0; e < 4; ++e) { VTs[(d0 + 2 * e) * 72 + j] = (bf16_t)(vw[e] & 0xffffu); VTs[(d0 + 2 * e + 1) * 72 + j] = (bf16_t)(vw[e] >> 16); } }
        __syncthreads();
        const bool local = kind && blk < 8;
#pragma unroll
        for (int i = 0; i < 2; ++i) {
            f32x4 a = {0.f, 0.f, 0.f, 0.f};
            a = mma_k<2>(Qs, 72, rb * 16, 0, Ks, 72, (cb0 + i) * 16, 0, a, lane);
#pragma unroll
            for (int e = 0; e < 4; ++e) { const int qi = rb * 16 + q * 4 + e, kc = (cb0 + i) * 16 + r;
                float sv = a[e] * 0.125f;
                if (local) { const int cs = min(max(qi - 8, 0), 48); const int ridx = rs + blk - qt + 7, cidx = min(max(kc - qi + 15, 0), 30);
                    sv = (kc >= cs && kc < cs + 16) ? sv + rpb[ridx * 31 + cidx] : -1e30f; }
                Sb[qi * 68 + kc] = sv; }
        }
        __syncthreads();
        {
            const int sub = tid & 7;
            const f32x4 s0 = *(const LAS f32x4*)(Sb + j * 68 + sub * 8), s1 = *(const LAS f32x4*)(Sb + j * 68 + sub * 8 + 4);
            float bm = fmaxf(fmaxf(fmaxf(s0[0], s0[1]), fmaxf(s0[2], s0[3])), fmaxf(fmaxf(s1[0], s1[1]), fmaxf(s1[2], s1[3])));
            bm = fmaxf(bm, __shfl_xor(bm, 1)); bm = fmaxf(bm, __shfl_xor(bm, 2)); bm = fmaxf(bm, __shfl_xor(bm, 4));
            const float mnew = fmaxf(mrun, bm), alpha = __expf(mrun - mnew);
            float pv[8];
#pragma unroll
            for (int e = 0; e < 4; ++e) { pv[e] = __expf(s0[e] - mnew); pv[4 + e] = __expf(s1[e] - mnew); }
            float ps = ((pv[0] + pv[1]) + (pv[2] + pv[3])) + ((pv[4] + pv[5]) + (pv[6] + pv[7]));
            ps += __shfl_xor(ps, 1); ps += __shfl_xor(ps, 2); ps += __shfl_xor(ps, 4);
            lrun = lrun * alpha + ps; mrun = mnew;
            *(LAS u32x4*)(Pb + j * 72 + sub * 8) = pack8(pv);
            if (sub == 0) ALPHA[j] = alpha;
        }
        __syncthreads();
#pragma unroll
        for (int i = 0; i < 2; ++i) {
#pragma unroll
            for (int e = 0; e < 4; ++e) oacc[i][e] *= ALPHA[rb * 16 + q * 4 + e];
            oacc[i] = mma_k<2>(Pb, 72, rb * 16, 0, VTs, 72, (cb0 + i) * 16, 0, oacc[i], lane);
        }
        __syncthreads();
    }
    if ((tid & 7) == 0) LSUM[j] = lrun;
    __syncthreads();
    bf16_t* br = (bf16_t*)(p.ws + WS_BR);
#pragma unroll
    for (int i = 0; i < 2; ++i)
#pragma unroll
        for (int e = 0; e < 4; ++e) { const int qi = rb * 16 + q * 4 + e; br[(size_t)(tq0 + qi) * DM + 768 + h * 64 + (cb0 + i) * 16 + r] = f2bf(oacc[i][e] / LSUM[qi]); }
    __syncthreads();
}

__device__ __forceinline__ void branch_phase(const Ctx& p, int l, LAS unsigned char* lds) {
    const int tid = get_tid(), lane = tid & 63, w = tid >> 6, r = lane & 15, q = lane >> 4;
    LAS bf16_t* As = (LAS bf16_t*)lds;
    const bf16_t* br = (const bf16_t*)(p.ws + WS_BR);
    const bf16_t* wb = (const bf16_t*)(p.ws + WS_W + (size_t)l * WL_STRIDE + WL_BR);
    const bf16_t* gates = (const bf16_t*)(p.ws + WS_GATES);
    bf16_t* merged = (bf16_t*)(p.ws + WS_MERGED);
    for (int tile = get_bid(); tile < 256; tile += get_nb()) {
        const int t0 = tile * 32;
#pragma unroll
        for (int i = 0; i < 8; ++i) { const int idx = i * 512 + tid, row = idx >> 7, c8 = (idx & 127) * 8;
            *(LAS u32x4*)(As + row * 1032 + c8) = *(const u32x4*)(br + (size_t)(t0 + row) * DM + c8); }
        __syncthreads();
#pragma unroll 1
        for (int ct = 0; ct < 8; ++ct) {
            const int d0 = w * 128 + ct * 16;
            f32x4 R[2] = {{0.f, 0.f, 0.f, 0.f}, {0.f, 0.f, 0.f, 0.f}};
            bf16x8 wf[8];
#pragma unroll
            for (int ks = 0; ks < 8; ++ks) wf[ks] = *(const bf16x8*)(wb + (size_t)(0 * 1024 + d0 + r) * 256 + ks * 32 + q * 8);
#pragma unroll
            for (int n = 0; n < 4; ++n) {
                bf16x8 wn[8];
                if (n < 3) {
#pragma unroll
                    for (int ks = 0; ks < 8; ++ks) wn[ks] = *(const bf16x8*)(wb + (size_t)((n + 1) * 1024 + d0 + r) * 256 + ks * 32 + q * 8);
                }
                u32x2 gw[2];
#pragma unroll
                for (int rt = 0; rt < 2; ++rt) gw[rt] = *(const u32x2*)(gates + (size_t)(t0 + rt * 16 + r) * NGATE + n * DM + d0 + q * 4);
                f32x4 U[2] = {{0.f, 0.f, 0.f, 0.f}, {0.f, 0.f, 0.f, 0.f}};
#pragma unroll
                for (int ks = 0; ks < 8; ++ks)
#pragma unroll
                    for (int rt = 0; rt < 2; ++rt) { const bf16x8 bfr = *(const LAS bf16x8*)(As + (rt * 16 + r) * 1032 + n * 256 + ks * 32 + q * 8);
                        U[rt] = __builtin_amdgcn_mfma_f32_16x16x32_bf16(wf[ks], bfr, U[rt], 0, 0, 0); }
#pragma unroll
                for (int rt = 0; rt < 2; ++rt) { R[rt][0] += bflo(gw[rt].x) * U[rt][0]; R[rt][1] += bfhi(gw[rt].x) * U[rt][1]; R[rt][2] += bflo(gw[rt].y) * U[rt][2]; R[rt][3] += bfhi(gw[rt].y) * U[rt][3]; }
                if (n < 3) {
#pragma unroll
                    for (int ks = 0; ks < 8; ++ks) wf[ks] = wn[ks];
                }
            }
#pragma unroll
            for (int rt = 0; rt < 2; ++rt) { u32x2 o; o.x = pk2(R[rt][0], R[rt][1]); o.y = pk2(R[rt][2], R[rt][3]);
                *(u32x2*)(merged + (size_t)(t0 + rt * 16 + r) * DM + d0 + q * 4) = o; }
        }
        __syncthreads();
    }
}

__device__ __forceinline__ void gate_sum_phase(const Ctx& p) {
    const int tid = get_tid();
    const bf16_t* gates = (const bf16_t*)(p.ws + WS_GATES);
    const bf16_t* up = (const bf16_t*)(p.ws + WS_PART);
    bf16_t* merged = (bf16_t*)(p.ws + WS_MERGED);
    const int NT = get_nb() * 512;
    for (int i = get_bid() * 512 + tid; i < T_ALL * 128; i += NT) {
        const int t = i >> 7, c8 = (i & 127) * 8;
        u32x4 g[4], u[4];
#pragma unroll
        for (int n = 0; n < 4; ++n) { g[n] = *(const u32x4*)(gates + (size_t)t * NGATE + n * DM + c8); u[n] = *(const u32x4*)(up + (size_t)t * NGATE + n * DM + c8); }
        float acc[8] = {0.f, 0.f, 0.f, 0.f, 0.f, 0.f, 0.f, 0.f};
#pragma unroll
        for (int n = 0; n < 4; ++n) { float gf[8], uf[8]; unpack8(g[n], gf); unpack8(u[n], uf);
#pragma unroll
            for (int e = 0; e < 8; ++e) acc[e] += gf[e] * uf[e]; }
        *(u32x4*)(merged + (size_t)t * DM + c8) = pack8(acc);
    }
}

__device__ __forceinline__ void na2_item(const Ctx& p, int l, int kind, int b, int h, int qt2, LAS unsigned char* lds) {
    const int tid = get_tid(), lane = tid & 63, w = tid >> 6, r = lane & 15, q = lane >> 4;
    LAS bf16_t* Qs = (LAS bf16_t*)lds;
    LAS bf16_t* Kb = Qs + 128 * 72;
    LAS bf16_t* Vb = Kb + 2 * 64 * 72;
    LAS bf16_t* Pw = Vb + 2 * 64 * 72 + w * (16 * 72);
    const bf16_t* proj = (const bf16_t*)(p.ws + WS_PROJ);
    const int tq0 = kind ? T_CTX + b * 1024 + qt2 * 128 : b * 256 + qt2 * 128;
    const int r0 = 2 * qt2;
    const int lo = kind ? min(max(r0 - 4, 0), 8) : 0, hi = kind ? min(max(r0 + 1 - 4, 0), 8) + 7 : 0;
    const int nloc = kind ? hi - lo + 1 : 0, nblk = nloc + 4;
    const int j = tid >> 3, d0 = (tid & 7) * 8;
#pragma unroll
    for (int i = 0; i < 2; ++i) { const int row = j + 64 * i; *(LAS u32x4*)(Qs + row * 72 + d0) = *(const u32x4*)(proj + (size_t)(tq0 + row) * NPROJ + C_NQ + h * 64 + d0); }
    auto loadkv = [&](int blk, u32x4& kreg, u32x4& vreg) {
        if (kind == 0 || blk < nloc) {
            const int tk = kind ? T_CTX + b * 1024 + (lo + blk) * 64 + j : b * 256 + blk * 64 + j;
            kreg = *(const u32x4*)(proj + (size_t)tk * NPROJ + C_NK + h * 64 + d0);
            vreg = *(const u32x4*)(proj + (size_t)tk * NPROJ + C_NV + h * 64 + d0);
        } else {
            const size_t off = ((size_t)((b * 4 + l) * 256 + (blk - nloc) * 64 + j) * 4 + h) * 64 + d0;
            const f32x4 k0 = *(const f32x4*)(PIN(I_CK) + off), k1 = *(const f32x4*)(PIN(I_CK) + off + 4);
            const f32x4 v0 = *(const f32x4*)(PIN(I_CV) + off), v1 = *(const f32x4*)(PIN(I_CV) + off + 4);
            kreg.x = pk2(k0[0], k0[1]); kreg.y = pk2(k0[2], k0[3]); kreg.z = pk2(k1[0], k1[1]); kreg.w = pk2(k1[2], k1[3]);
            vreg.x = pk2(v0[0], v0[1]); vreg.y = pk2(v0[2], v0[3]); vreg.z = pk2(v1[0], v1[1]); vreg.w = pk2(v1[2], v1[3]);
        }
    };
    u32x4 knext, vnext;
    loadkv(0, knext, vnext);
    f32x4 oacc[4];
#pragma unroll
    for (int dt = 0; dt < 4; ++dt) oacc[dt] = (f32x4){0.f, 0.f, 0.f, 0.f};
    float mrun[4] = {-1e30f, -1e30f, -1e30f, -1e30f}, lrun[4] = {0.f, 0.f, 0.f, 0.f};
    const float* rpb = PIN(I_RPB) + (size_t)(l * 4 + h) * 15 * 31;
    const int qrow = r0 + (w >> 2);
    const int rsq = min(max(qrow - 4, 0), 8);
    for (int blk = 0; blk < nblk; ++blk) {
        LAS bf16_t* Ks = Kb + (blk & 1) * (64 * 72); LAS bf16_t* VTs = Vb + (blk & 1) * (64 * 72);
        *(LAS u32x4*)(Ks + j * 72 + d0) = knext;
        { const unsigned vw[4] = {vnext.x, vnext.y, vnext.z, vnext.w};
#pragma unroll
            for (int e = 0; e < 4; ++e) { VTs[(d0 + 2 * e) * 72 + j] = (bf16_t)(vw[e] & 0xffffu); VTs[(d0 + 2 * e + 1) * 72 + j] = (bf16_t)(vw[e] >> 16); } }
        if (blk + 1 < nblk) loadkv(blk + 1, knext, vnext);
        __syncthreads();
        const bool local = kind && blk < nloc;
        const int kr = lo + blk;
        const bool rowok = !local || (kr >= rsq && kr < rsq + 8);
        f32x4 sc[4];
#pragma unroll
        for (int cb = 0; cb < 4; ++cb) { f32x4 a = {0.f, 0.f, 0.f, 0.f}; a = mma_k<2>(Qs, 72, w * 16, 0, Ks, 72, cb * 16, 0, a, lane);
#pragma unroll
            for (int e = 0; e < 4; ++e) { float sv = a[e] * 0.125f;
                if (local) { const int qc = (w & 3) * 16 + q * 4 + e, kc = cb * 16 + r, cs = min(max(qc - 8, 0), 48), cidx = min(max(kc - qc + 15, 0), 30);
                    sv = (rowok && kc >= cs && kc < cs + 16) ? sv + rpb[(kr - qrow + 7) * 31 + cidx] : -1e30f; }
                a[e] = sv; }
            sc[cb] = a; }
        float alpha[4];
#pragma unroll
        for (int e = 0; e < 4; ++e) {
            float bm = fmaxf(fmaxf(sc[0][e], sc[1][e]), fmaxf(sc[2][e], sc[3][e]));
            bm = fmaxf(bm, __shfl_xor(bm, 1)); bm = fmaxf(bm, __shfl_xor(bm, 2)); bm = fmaxf(bm, __shfl_xor(bm, 4)); bm = fmaxf(bm, __shfl_xor(bm, 8));
            const float mnew = fmaxf(mrun[e], bm); alpha[e] = __expf(mrun[e] - mnew); mrun[e] = mnew;
            float ps = 0.f;
#pragma unroll
            for (int cb = 0; cb < 4; ++cb) { const float sv = sc[cb][e]; const float pv = (sv > -1e29f) ? __expf(sv - mnew) : 0.f; sc[cb][e] = pv; ps += pv; }
            ps += __shfl_xor(ps, 1); ps += __shfl_xor(ps, 2); ps += __shfl_xor(ps, 4); ps += __shfl_xor(ps, 8);
            lrun[e] = lrun[e] * alpha[e] + ps;
        }
#pragma unroll
        for (int cb = 0; cb < 4; ++cb)
#pragma unroll
            for (int e = 0; e < 4; ++e) Pw[(q * 4 + e) * 72 + cb * 16 + r] = f2bf(sc[cb][e]);
#pragma unroll
        for (int dt = 0; dt < 4; ++dt)
#pragma unroll
            for (int e = 0; e < 4; ++e) oacc[dt][e] *= alpha[e];
        LDS_WAIT();
#pragma unroll
        for (int dt = 0; dt < 4; ++dt) oacc[dt] = mma_k<2>(Pw, 72, 0, 0, VTs, 72, dt * 16, 0, oacc[dt], lane);
        LDS_WAIT();
    }
    bf16_t* br = (bf16_t*)(p.ws + WS_BR);
#pragma unroll
    for (int dt = 0; dt < 4; ++dt)
#pragma unroll
        for (int e = 0; e < 4; ++e) br[(size_t)(tq0 + w * 16 + q * 4 + e) * DM + 768 + h * 64 + dt * 16 + r] = f2bf(oacc[dt][e] / lrun[e]);
    __syncthreads();
}

__device__ __forceinline__ void mixer_phase1(const Ctx& p, int l, LAS unsigned char* lds, int qoff) {
    const int tid = get_tid();
    volatile LAS int* slot = (volatile LAS int*)(lds + LDS_MAIN + 32);
    unsigned* ctr = (unsigned*)(p.ws + WS_CTR) + l * 64 + qoff;
    int it = get_bid();
    while (it < 576) {
        if (it < 32) { const int r = it; gla_state_item(p, l, 1, r >> 3, (r >> 1) & 3, r & 1, lds); }
        else if (it < 64) { const int r = it - 32; ret_state_item(p, l, 1, r >> 3, (r >> 1) & 3, r & 1, lds); }
        else if (it < 192) { const int r = it - 64; na2_item(p, l, 1, r >> 5, (r >> 3) & 3, r & 7, lds); }
        else if (it < 320) { const int r = it - 192;
            if (r < 64) { const int rr = r; s5_item(p, l, 1, rr >> 4, (rr >> 3) & 1, (rr >> 2) & 1, (rr & 3) * 4, lds); }
            else { const int rr = r - 64; s5_item(p, l, 0, rr >> 2, (rr >> 1) & 1, rr & 1, 0, lds); }
            __syncthreads(); }
        else if (it < 448) { const int r = it - 320; gla_state_item(p, l, 0, r >> 3, (r >> 1) & 3, r & 1, lds); ret_state_item(p, l, 0, r >> 3, (r >> 1) & 3, r & 1, lds); }
        else if (it < 576) { const int r = it - 448; na2_item(p, l, 0, r >> 3, (r >> 1) & 3, r & 1, lds); }
        if (tid == 0) *slot = (int)atomicAdd(ctr, 1u) + get_nb();
        __syncthreads();
        it = *slot;
        __syncthreads();
    }
}
__device__ __forceinline__ void mixer_phase2(const Ctx& p, int l, LAS unsigned char* lds, int qoff) {
    const int tid = get_tid();
    volatile LAS int* slot = (volatile LAS int*)(lds + LDS_MAIN + 32);
    unsigned* ctr = (unsigned*)(p.ws + WS_CTR) + l * 64 + 32 + qoff;
    int it = get_bid();
    while (it < 1152) {
        if (it < 128) s5_glu_item(p, l, 127 - it, lds);
        else {
            const int r = (it - 128) & 511; const bool gla = it >= 640;
            int path, b, h, c;
            if (r < 256) { path = 1; b = r >> 6; h = (r >> 4) & 3; c = r & 15; } else { const int rr = r - 256; path = 0; b = rr >> 4; h = (rr >> 2) & 3; c = rr & 3; }
            if (gla) gla_out_item(p, l, path, b, h, c, lds); else ret_out_item(p, l, path, b, h, c, lds);
        }
        if (tid == 0) *slot = (int)atomicAdd(ctr, 1u) + get_nb();
        __syncthreads();
        it = *slot;
        __syncthreads();
    }
}

__global__ void __launch_bounds__(512) fwd_megakernel(Params p) {
    extern __shared__ __attribute__((aligned(16))) unsigned char smem_raw[];
    LAS unsigned char* lds = (LAS unsigned char*)smem_raw;
    cg::grid_group grid = cg::this_grid();
    const int G = get_nb(), c = get_bid();
    const int ph_lo = p.ph_lo, ph_hi = p.ph_hi;
    volatile LAS unsigned* bst = (volatile LAS unsigned*)(lds + LDS_MAIN);
    if (threadIdx.x < 16) bst[threadIdx.x] = 0u;
    __syncthreads();
    if (threadIdx.x == 0) (void)xb_add(&((unsigned*)(p.ws + WS_BAR))[XB_XCNT(xb_xcc_id())], 1u);
    if (ph_hi > 1000) grid.sync();
#define GRID_SYNC() xcd_barrier((unsigned*)(p.ws + WS_BAR), bst)
#ifndef NO_P0
    if (ph_lo == 0) phase0(p, lds);
#if defined(PROBE_DUP) && PROBE_DUP == 100
    GRID_SYNC(); if (ph_lo == 0) phase0(p, lds);
#endif
#endif
    for (int ph = (ph_lo == 0 ? 1 : ph_lo); ph < ph_hi; ++ph) {
        if (ph > ph_lo) GRID_SYNC();
        Ctx q;
        { GAS unsigned char* ws = (GAS unsigned char*)p.ws; GAS float* out = (GAS float*)p.out; asm volatile("" : "+s"(ws), "+s"(out)); q.ws = (unsigned char*)ws; q.out = (float*)out; q.in = (const GAS float* const*)(q.ws + WS_TAB); }
        if (ph == 41) { row_phase(q, 4, 0); continue; }
        const int l = (ph - 1) / 10, k = (ph - 1) % 10;
#if !(defined(PROBE_DUP) && PROBE_DUP < 100)
#define QOFF 0
#endif
#if defined(PROBE_DUP) && PROBE_DUP < 100
#define QOFF (rep * 8)
        for (int rep = 0; rep < ((k == PROBE_DUP) ? 2 : 1); ++rep) {
        if (rep) GRID_SYNC();
#endif
#if defined(PROBE_DUP) && PROBE_DUP == 101
        GRID_SYNC();
#endif
        unsigned char* wl = q.ws + WS_W + (size_t)l * WL_STRIDE;
        if (k == 0) { row_phase(q, l, 0); continue; }
#ifndef NO_M1
        if (k == 2) { mixer_phase1(q, l, lds, QOFF); continue; }
#endif
#ifndef NO_M2
        if (k == 3) { mixer_phase2(q, l, lds, QOFF); continue; }
#endif
        if (k == 7) { row_phase(q, l, 1); continue; }
        if (k == 5) { gate_sum_phase(q); continue; }
#ifndef NO_GEMM
        pg8::Sched S; pg8::Gemm g; pg8::Epi E;
        E.l = l; E.bias = ((const float*)q.in[I_BMG]) + (size_t)l * 4096; E.nak = q.out + O_NAK; E.nav = q.out + O_NAV;
        E.g16 = (bf16_t*)(q.ws + WS_GATES); E.f32 = (float*)(q.ws + WS_PART);
        if (k == 1) { S.init(32, 28, G, c, 0, 0u); g = pg8::Gemm{(const bf16_t*)(q.ws + WS_H), (const bf16_t*)(wl + WL_CAT), 1024, 1024, 1024}; E.mode = 0; E.o16 = (bf16_t*)(q.ws + WS_PROJ); }
        else if (k == 4) { S.init(32, 16, G, c, 3, 0u); g = pg8::Gemm{(const bf16_t*)(q.ws + WS_BR), (const bf16_t*)(wl + WL_BR), 256, 1024, 256}; E.mode = 4; E.o16 = (bf16_t*)(q.ws + WS_PART); }
        else if (k == 6) { S.init(32, 8, G, c, 1, 512u * 2u); g = pg8::Gemm{(const bf16_t*)(q.ws + WS_MERGED), (const bf16_t*)(wl + WL_OUT), 512, 1024, 1024}; E.mode = 2; E.o16 = nullptr; }
        else if (k == 8) { S.init(32, 16, G, c, 0, 0u); g = pg8::Gemm{(const bf16_t*)(q.ws + WS_H), (const bf16_t*)(wl + WL_M1), 1024, 1024, 1024}; E.mode = 3; E.o16 = (bf16_t*)(q.ws + WS_GATES); }
        else { S.init(32, 8, G, c, 1, 2048u * 2u); g = pg8::Gemm{(const bf16_t*)(q.ws + WS_GATES), (const bf16_t*)(wl + WL_M2), 2048, 4096, 4096}; E.mode = 2; E.o16 = nullptr; }
        pg8::gemm_phase(lds, g, S, E);
#endif
#if defined(PROBE_DUP) && PROBE_DUP < 100
        }
#endif
    }
}

extern "C" void kernel_launch(void* const* d_in, const int* in_sizes, int n_in, void* d_out, int out_size, void* d_ws, size_t ws_size, hipStream_t stream) {
    static int grid_blocks = 0;
    if (grid_blocks == 0) {
        if (n_in != N_IN || ws_size < WS_END) { fprintf(stderr, "kernel_launch: unexpected inputs (n_in %d, ws %zu, need %zu)\n", n_in, ws_size, (size_t)WS_END); grid_blocks = -1; return; }
        int dev = 0, cus = 0, per_cu = 0;
        hipGetDevice(&dev);
        hipDeviceGetAttribute(&cus, hipDeviceAttributeMultiprocessorCount, dev);
        if (hipFuncSetAttribute((const void*)fwd_megakernel, hipFuncAttributeMaxDynamicSharedMemorySize, LDS_BYTES) != hipSuccess) { fprintf(stderr, "kernel_launch: hipFuncSetAttribute failed\n"); (void)hipGetLastError(); }
        if (hipOccupancyMaxActiveBlocksPerMultiprocessor(&per_cu, (const void*)fwd_megakernel, 512, LDS_BYTES) != hipSuccess || per_cu < 1) { fprintf(stderr, "kernel_launch: occupancy query gave %d\n", per_cu); (void)hipGetLastError(); per_cu = 1; }
        grid_blocks = cus;
    }
    if (grid_blocks < 0) return;
    if (hipMemsetAsync((unsigned char*)d_ws + WS_BAR, 0, 16384 + 4096, stream) != hipSuccess) { fprintf(stderr, "kernel_launch: memset failed\n"); return; }
    Params p{};
    for (int i = 0; i < N_IN; ++i) p.in[i] = (const float*)d_in[i];
    p.out = (float*)d_out; p.ws = (unsigned char*)d_ws; p.ph_lo = 0; p.ph_hi = 42;
    void* args[] = {&p};
    hipError_t e = hipLaunchCooperativeKernel((const void*)fwd_megakernel, dim3(grid_blocks), dim3(512), args, LDS_BYTES, stream);
    if (e != hipSuccess) fprintf(stderr, "cooperative launch failed: %s (grid %d)\n", hipGetErrorString(e), grid_blocks);
}
```
